# Optimizing an MI355X kernel written in HIP

```python
import jax, jax.numpy as jnp
from jax import lax
import numpy as np

D_MODEL = 1024
BATCH = 4
SEQ = 8192
DEPTH = 1

RWKV_HEADS = 8
RWKV_HEAD_DIM = 64
RWKV_WIDTH = RWKV_HEADS * RWKV_HEAD_DIM
DECAY_LORA = 64
ICLR_LORA = 64
GATE_LORA = 160
LNX_EPS = 64e-5
MOBA_HEADS = 8
MOBA_HEAD_DIM = 64
MOBA_WIDTH = MOBA_HEADS * MOBA_HEAD_DIM
MOBA_BLOCK = 256
MOBA_TOPK = 3
MOBA_Q_CHUNK = 64
N_BRANCH = 2
BRANCH_WIDTH = 512
RWKV_COLS = 3 * RWKV_WIDTH + DECAY_LORA + ICLR_LORA + GATE_LORA
MOBA_COLS = 3 * MOBA_WIDTH
GATE_COLS = N_BRANCH * D_MODEL
IN_COLS = RWKV_COLS + MOBA_COLS + GATE_COLS
RWKV_SPLITS = (RWKV_WIDTH, 2 * RWKV_WIDTH, 3 * RWKV_WIDTH,
               3 * RWKV_WIDTH + DECAY_LORA, 3 * RWKV_WIDTH + DECAY_LORA + ICLR_LORA)
PEER_HEADS = 8
PEER_N_KEYS = 128
PEER_N_EXPERTS = PEER_N_KEYS * PEER_N_KEYS
PEER_KEY_DIM = 128
PEER_TOPK = 16
PEER_TOKEN_CHUNK = 128

NORM_EPS = 1e-6
NEG_INF = -1e30

kernel_name = "rwkv7_moba_gated_peer_adaln_block"


def rms_norm(x, gain, eps=NORM_EPS):
    xf = x.astype(jnp.float32)
    y = xf * lax.rsqrt(jnp.mean(xf * xf, axis=-1, keepdims=True) + eps)
    return (y * gain.astype(jnp.float32)).astype(x.dtype)


def rwkv7_scan(r, w, k, v, a, b):
    B, S, H, N = r.shape

    def step(state, inp):
        r_t, w_t, k_t, v_t, a_t, b_t = inp
        sa = jnp.einsum('bhvk,bhk->bhv', state, a_t)
        state = (state * w_t[:, :, None, :] + sa[..., None] * b_t[:, :, None, :]
                 + v_t[..., None] * k_t[:, :, None, :])
        return state, jnp.einsum('bhvk,bhk->bhv', state, r_t)

    xs = tuple(jnp.swapaxes(t, 0, 1) for t in (r, w, k, v, a, b))
    state0 = jnp.zeros((B, H, N, N), jnp.float32)
    _, out = lax.scan(step, state0, xs)
    return jnp.swapaxes(out, 0, 1)


def rwkv7_branch(p, mu, w0, w2_decay, a0, a2_iclr, g2_gate, k_k, k_a, r_k, lnx_w, lnx_b):
    B, S, _ = p.shape
    H, N = RWKV_HEADS, RWKV_HEAD_DIM
    f32 = jnp.float32
    p_prev = jnp.pad(p, ((0, 0), (1, 0), (0, 0)))[:, :-1]
    xm = p + (p_prev - p) * mu
    r, k, v, wl, al, gl = jnp.split(xm, RWKV_SPLITS, axis=-1)
    w_log = -jax.nn.softplus(-(w0 + jnp.tanh(wl) @ w2_decay).astype(f32)) - 0.5
    decay = jnp.exp(-jnp.exp(w_log))
    a = jax.nn.sigmoid((a0 + al @ a2_iclr).astype(f32))
    g = jax.nn.sigmoid(gl) @ g2_gate
    r, k, v = r.astype(f32), k.astype(f32), v.astype(f32)

    def heads(t):
        return t.reshape(B, S, H, N)

    kk = heads(k * k_k)
    kk = kk / jnp.maximum(jnp.sqrt(jnp.sum(kk * kk, axis=-1, keepdims=True)), 1e-12)
    k = k * (1.0 + (a - 1.0) * k_a)
    out = rwkv7_scan(heads(r), heads(decay), heads(k), heads(v), -kk, kk * heads(a))
    mean = jnp.mean(out, axis=-1, keepdims=True)
    var = jnp.mean(jnp.square(out - mean), axis=-1, keepdims=True)
    out = ((out - mean) * lax.rsqrt(var + LNX_EPS)).reshape(B, S, RWKV_WIDTH) * lnx_w + lnx_b
    bonus = jnp.sum(heads(r) * heads(k) * r_k, axis=-1, keepdims=True) * heads(v)
    y = (out + bonus.reshape(B, S, RWKV_WIDTH)) * g
    return y.astype(p.dtype)


def moba_branch(q, k, v, q_norm_g, k_norm_g):
    B, S, _ = q.shape
    H, Dh, BL, QC = MOBA_HEADS, MOBA_HEAD_DIM, MOBA_BLOCK, MOBA_Q_CHUNK
    out_dtype = q.dtype

    def heads(t):
        return t.reshape(B, S, H, Dh).transpose(0, 2, 1, 3).astype(jnp.float32)

    q = rms_norm(heads(q), q_norm_g) * (Dh ** -0.5)
    k = rms_norm(heads(k), k_norm_g)
    v = heads(v)
    nb = -(-S // BL)
    pad = nb * BL - S
    kp = jnp.pad(k, ((0, 0), (0, 0), (0, pad), (0, 0)))
    vp = jnp.pad(v, ((0, 0), (0, 0), (0, pad), (0, 0)))
    kblk = kp.reshape(B, H, nb, BL, Dh)
    vblk = vp.reshape(B, H, nb, BL, Dh)
    kmean = jnp.mean(kblk, axis=3)
    n_sel = min(MOBA_TOPK, nb)
    qblk = jnp.arange(S) // BL
    gate = jnp.einsum('bhsd,bhnd->bhsn', q, kmean)
    gate = jnp.where(jnp.arange(nb)[None, :] < qblk[:, None], gate, NEG_INF)
    _, sel = lax.top_k(gate, n_sel)
    bi = jnp.arange(B)[:, None, None, None]
    hi = jnp.arange(H)[None, :, None, None]

    def chunk(ci):
        t0 = ci * QC
        blk = t0 // BL
        qc = lax.dynamic_slice_in_dim(q, t0, QC, axis=2)
        selc = lax.dynamic_slice_in_dim(sel, t0, QC, axis=2)
        kg = kblk[bi, hi, selc]
        vg = vblk[bi, hi, selc]
        k_own = lax.dynamic_slice_in_dim(kp, blk * BL, BL, axis=2)
        v_own = lax.dynamic_slice_in_dim(vp, blk * BL, BL, axis=2)
        s_sel = jnp.einsum('bhqd,bhqjkd->bhqjk', qc, kg)
        s_sel = jnp.where((jnp.arange(n_sel) < blk)[:, None], s_sel, NEG_INF)
        s_own = jnp.einsum('bhqd,bhkd->bhqk', qc, k_own)
        qpos = t0 + jnp.arange(QC)
        kpos = blk * BL + jnp.arange(BL)
        s_own = jnp.where(kpos[None, :] <= qpos[:, None], s_own, NEG_INF)
        scores = jnp.concatenate([s_sel.reshape(B, H, QC, n_sel * BL), s_own], axis=-1)
        p = jax.nn.softmax(scores, axis=-1)
        p_sel = p[..., :n_sel * BL].reshape(B, H, QC, n_sel, BL)
        p_own = p[..., n_sel * BL:]
        return (jnp.einsum('bhqjk,bhqjkd->bhqd', p_sel, vg)
                + jnp.einsum('bhqk,bhkd->bhqd', p_own, v_own))

    out = lax.map(chunk, jnp.arange(S // QC))
    out = out.transpose(1, 0, 3, 2, 4).reshape(B, S, H * Dh)
    return out.astype(out_dtype)


def peer_ffn(h, w_peer_q, sub_keys, u_tab, v_tab):
    B, S, D = h.shape
    HP, K = PEER_HEADS, PEER_TOPK
    q = (h @ w_peer_q).reshape(B, S, HP, 2, PEER_KEY_DIM).astype(jnp.float32)
    s1 = jnp.einsum('bshd,hnd->bshn', q[..., 0, :], sub_keys[0].astype(jnp.float32))
    s2 = jnp.einsum('bshd,hnd->bshn', q[..., 1, :], sub_keys[1].astype(jnp.float32))
    v1, i1 = lax.top_k(s1, K)
    v2, i2 = lax.top_k(s2, K)
    comb = (v1[..., :, None] + v2[..., None, :]).reshape(B, S, HP, K * K)
    sc, ci = lax.top_k(comb, K)
    e1 = jnp.take_along_axis(i1, ci // K, axis=-1)
    e2 = jnp.take_along_axis(i2, ci % K, axis=-1)
    idx = e1 * PEER_N_KEYS + e2
    gw = jax.nn.softmax(sc, axis=-1)
    n_ch = (B * S) // PEER_TOKEN_CHUNK
    hc = h.reshape(n_ch, PEER_TOKEN_CHUNK, D)
    idxc = idx.reshape(n_ch, PEER_TOKEN_CHUNK, HP * K)
    gwc = gw.reshape(n_ch, PEER_TOKEN_CHUNK, HP * K).astype(h.dtype)

    def chunk(args):
        h_c, i_c, g_c = args
        act = jax.nn.gelu(jnp.einsum('td,ted->te', h_c, u_tab[i_c]), approximate=False) * g_c
        return jnp.einsum('te,ted->td', act, v_tab[i_c])

    out = lax.map(chunk, (hc, idxc, gwc))
    return out.reshape(B, S, D)


def setup_inputs(seed: int = 0) -> dict:
    key = jax.random.key(seed)
    ks = jax.random.split(key, 32)
    nrm = jax.random.normal
    D = D_MODEL
    return {
        "x": nrm(ks[0], (BATCH, SEQ, D), jnp.float32),
        "c": nrm(ks[1], (BATCH, D), jnp.float32),
        "w_ada": nrm(ks[2], (D, 6 * D), jnp.float32) * (0.5 * D ** -0.5),
        "b_ada": nrm(ks[3], (6 * D,), jnp.float32) * 0.01,
        "norm1_g": 1.0 + 0.02 * nrm(ks[4], (D,), jnp.float32),
        "w_in": nrm(ks[5], (D, IN_COLS), jnp.float32) * D ** -0.5,
        "mu_rwkv": jax.random.uniform(ks[6], (RWKV_COLS,), jnp.float32),
        "w0": jax.random.uniform(ks[7], (RWKV_WIDTH,), jnp.float32, -6.0, 0.0),
        "w2_decay": nrm(ks[8], (DECAY_LORA, RWKV_WIDTH), jnp.float32) * DECAY_LORA ** -0.5,
        "a0": 0.1 * nrm(ks[9], (RWKV_WIDTH,), jnp.float32),
        "a2_iclr": nrm(ks[10], (ICLR_LORA, RWKV_WIDTH), jnp.float32) * ICLR_LORA ** -0.5,
        "g2_gate": nrm(ks[11], (GATE_LORA, RWKV_WIDTH), jnp.float32) * GATE_LORA ** -0.5,
        "k_k": 0.85 + 0.02 * nrm(ks[12], (RWKV_WIDTH,), jnp.float32),
        "k_a": 1.0 + 0.02 * nrm(ks[13], (RWKV_WIDTH,), jnp.float32),
        "r_k": 0.1 * nrm(ks[14], (RWKV_HEADS, RWKV_HEAD_DIM), jnp.float32),
        "lnx_w": 1.0 + 0.02 * nrm(ks[15], (RWKV_WIDTH,), jnp.float32),
        "lnx_b": 0.01 * nrm(ks[16], (RWKV_WIDTH,), jnp.float32),
        "q_norm_g": 1.0 + 0.02 * nrm(ks[17], (MOBA_HEAD_DIM,), jnp.float32),
        "k_norm_g": 1.0 + 0.02 * nrm(ks[18], (MOBA_HEAD_DIM,), jnp.float32),
        "w_branch": nrm(ks[19], (N_BRANCH, BRANCH_WIDTH, D), jnp.float32) * BRANCH_WIDTH ** -0.5,
        "w_out": nrm(ks[20], (D, D), jnp.float32) * D ** -0.5,
        "norm2_g": 1.0 + 0.02 * nrm(ks[21], (D,), jnp.float32),
        "w_peer_q": nrm(ks[22], (D, PEER_HEADS * 2 * PEER_KEY_DIM), jnp.float32) * D ** -0.5,
        "peer_sub_keys": nrm(ks[23], (2, PEER_HEADS, PEER_N_KEYS, PEER_KEY_DIM), jnp.float32) * PEER_KEY_DIM ** -0.5,
        "peer_u": nrm(ks[24], (PEER_N_EXPERTS, D), jnp.float32) * D ** -0.5,
        "peer_v": nrm(ks[25], (PEER_N_EXPERTS, D), jnp.float32) * (PEER_HEADS * PEER_TOPK) ** -0.5,
    }


def reference(x, c, w_ada, b_ada, norm1_g, w_in, mu_rwkv, w0, w2_decay, a0, a2_iclr, g2_gate,
              k_k, k_a, r_k, lnx_w, lnx_b, q_norm_g, k_norm_g, w_branch, w_out, norm2_g,
              w_peer_q, peer_sub_keys, peer_u, peer_v):
    B, S, D = x.shape
    for _ in range(DEPTH):
        ada = jax.nn.silu(c) @ w_ada + b_ada
        shift1, scale1, gate1, shift2, scale2, gate2 = jnp.split(ada[:, None, :], 6, axis=-1)
        h = rms_norm(x, norm1_g) * (1.0 + scale1) + shift1
        proj = h @ w_in
        p_rwkv, p_moba, p_gate = jnp.split(proj, (RWKV_COLS, RWKV_COLS + MOBA_COLS), axis=-1)
        y_a = rwkv7_branch(p_rwkv, mu_rwkv, w0, w2_decay, a0, a2_iclr, g2_gate,
                           k_k, k_a, r_k, lnx_w, lnx_b)
        q, k, v = jnp.split(p_moba, 3, axis=-1)
        y_b = moba_branch(q, k, v, q_norm_g, k_norm_g)
        ys = jnp.einsum('bsnc,ncd->bsnd', jnp.stack([y_a, y_b], axis=2), w_branch)
        gates = jax.nn.sigmoid(p_gate.reshape(B, S, N_BRANCH, D))
        mixed = jnp.sum(gates * ys, axis=2) @ w_out
        x = x + gate1 * mixed
        h2 = rms_norm(x, norm2_g) * (1.0 + scale2) + shift2
        x = x + gate2 * peer_ffn(h2, w_peer_q, peer_sub_keys, peer_u, peer_v)
    return x
```

```cpp
#include <hip/hip_runtime.h>
#include <hip/hip_cooperative_groups.h>
#include <cstdio>
namespace cg = cooperative_groups;
namespace pg8 {
#define PG8_LAS __attribute__((address_space(3)))
typedef unsigned short bf16_t;
typedef short bf16x8 __attribute__((ext_vector_type(8)));
typedef float f32x4 __attribute__((ext_vector_type(4)));
typedef unsigned u32x4 __attribute__((ext_vector_type(4)));
constexpr int BM = 256, BK = 64, HALF = 128, HTB = HALF * BK * 2  , STAGE_BYTES = 8 * HTB, NXCD = 8, WGM = 8;

__host__ __device__ __forceinline__ int lds_byte(int r, int c) { const int st = (r >> 4) * 2 + (c >> 5), rr = r & 15, cc = c & 31, ob = rr * 64 + cc * 2; return st * 1024 + (ob ^ (((ob >> 9) & 1) << 5)); }
__host__ __device__ __forceinline__ void stage_rc(int b, int& R, int& C) { const int st = b / 1024, sb = b % 1024, swz = sb ^ (((sb >> 9) & 1) << 5); R = (st >> 1) * 16 + swz / 64; C = (st & 1) * 32 + (swz % 64) / 2; }
__host__ __device__ __forceinline__ int perm32(int rho) { const int n = rho >> 4, i = rho & 15; return 8 * (i >> 2) + 4 * n + (i & 3); }

struct Unit { int pm, pn; };
struct Gemm { const bf16_t* A; const bf16_t* Bt; int M, N, K; };

struct StaticOrder {
    int nM, nN, nwg, G, c;
    __host__ __device__ void init(int M, int N, int G_, int c_) { nM = M / BM; nN = N / BM; nwg = nM * nN; G = G_; c = c_; }
    __host__ __device__ bool next(int i, Unit& u) const {
        const long L = (long)i * G + c; if (L >= nwg) return false;
        int wgid = (int)L; { const int q = nwg / NXCD, r = nwg % NXCD, xcd = wgid % NXCD, off = wgid / NXCD; wgid = (xcd < r ? xcd * (q + 1) : r * (q + 1) + (xcd - r) * q) + off; }
        const int nig = WGM * nN, gid = wgid / nig, fm = gid * WGM, gsz = (nM - fm) < WGM ? (nM - fm) : WGM;
        u.pm = fm + ((wgid % nig) % gsz); u.pn = (wgid % nig) / gsz; return true;
    }
    __device__ __forceinline__ void a_ready(const Unit&) const {}
    __device__ __forceinline__ void done(const Unit&) const {}
};
__device__ __forceinline__ unsigned cvt_pk_bf16(float lo, float hi) { unsigned r; asm volatile("v_cvt_pk_bf16_f32 %0, %1, %2" : "=v"(r) : "v"(lo), "v"(hi)); return r; }
typedef float f32x2 __attribute__((ext_vector_type(2)));
template <class Epi, class Sched, bool STAMP = false>
__device__ __forceinline__ void gemm_phase(PG8_LAS unsigned char* lds, const Gemm g, const Sched& S, const Epi& E, unsigned long long* stamps) {
    int tid_ = threadIdx.x; asm volatile("" : "+v"(tid_));
    const int tid = tid_, wid = __builtin_amdgcn_readfirstlane(tid >> 6), lane = tid & 63, wr = wid >> 2, wc = wid & 3, fr = lane & 15, fq = lane >> 4;
    const int K = g.K, nt = K / BK;
    int ts_lo = 0, ts_hi = 0, nts = 0; const unsigned long long rt_entry = STAMP ? (unsigned long long)wall_clock64() : 0ull;
#define PG8_STAMP() do { if (STAMP && wid == 0 && nts < 64) { const unsigned long long _c = (unsigned long long)clock64(); \
        ts_lo = (lane == nts) ? (int)(unsigned)_c : ts_lo; ts_hi = (lane == nts) ? (int)(unsigned)(_c >> 32) : ts_hi; ++nts; } } while (0)
    PG8_STAMP();
    unsigned voffA[2], voffB[2];
#pragma unroll
    for (int i = 0; i < 2; ++i) { int R, C; stage_rc(tid * 16 + i * 8192, R, C); const int Rb = Epi::PERM ? ((R & ~31) + perm32(R & 31)) : R;
        voffA[i] = (unsigned)(R * K + C) * 2u; voffB[i] = (unsigned)(Rb * K + C) * 2u; }
    const size_t kstep = (size_t)(BK * 2);
    const size_t hstep = (size_t)HALF * K * 2;
    const size_t tstep = 2 * hstep;
    const unsigned ldsw = (unsigned)wid * 1024u;
    const int aoff = lds_byte(wr * 64 + fr, fq * 8), boff = lds_byte(wc * 32 + fr, fq * 8);
#define PG8_SA(b, h) (((b) * 2 + (h)) * HTB)
#define PG8_SB(b, h) ((4 + (b) * 2 + (h)) * HTB)
#define PG8_STAGE(bufoff, gbase, voff) do { _Pragma("unroll") for (int _i = 0; _i < 2; ++_i) \
        __builtin_amdgcn_global_load_lds((const unsigned*)((const char*)(gbase) + (voff)[_i]), (PG8_LAS unsigned*)(lds + (bufoff) + ldsw + _i * 8192), 16, 0, 0); } while (0)
#define PG8_LDA(dst, b, h) do { _Pragma("unroll") for (int m = 0; m < 4; ++m) _Pragma("unroll") for (int k = 0; k < 2; ++k) dst[m][k] = *(const PG8_LAS bf16x8*)(lds + PG8_SA(b, h) + aoff + m * 2048 + k * 1024); } while (0)
#define PG8_LDB(dst, b, h) do { _Pragma("unroll") for (int n = 0; n < 2; ++n) _Pragma("unroll") for (int k = 0; k < 2; ++k) dst[n][k] = *(const PG8_LAS bf16x8*)(lds + PG8_SB(b, h) + boff + n * 2048 + k * 1024); } while (0)
#define PG8_MMA(ai, bj, At, Bt) do { __builtin_amdgcn_s_setprio(1); _Pragma("unroll") for (int m = 0; m < 4; ++m) _Pragma("unroll") for (int n = 0; n < 2; ++n) _Pragma("unroll") for (int k = 0; k < 2; ++k) \
        acc[ai][bj][m][n] = __builtin_amdgcn_mfma_f32_16x16x32_bf16(Bt[n][k], At[m][k], acc[ai][bj][m][n], 0, 0, 0); __builtin_amdgcn_s_setprio(0); } while (0)
#define PG8_WAIT_V(n) asm volatile("s_waitcnt vmcnt(" #n ")" ::: "memory")
#define PG8_WAIT_L(n) asm volatile("s_waitcnt lgkmcnt(" #n ")" ::: "memory")
#define PG8_BAR __builtin_amdgcn_s_barrier()
#define PG8_SCHED __builtin_amdgcn_sched_barrier(0)
    Unit cur, nxt; int ui = 0;
    if (!S.next(0, cur)) return;
    f32x4 acc[2][2][4][2];
#pragma unroll
    for (int a = 0; a < 2; ++a)
#pragma unroll
        for (int b = 0; b < 2; ++b)
#pragma unroll
            for (int m = 0; m < 4; ++m)
#pragma unroll
                for (int n = 0; n < 2; ++n) acc[a][b][m][n] = (f32x4){0.f, 0.f, 0.f, 0.f};
    bf16x8 At[4][2], B0[2][2], B1[2][2];
    const char* cA = (const char*)g.A + (size_t)cur.pm * tstep; const char* cB = (const char*)g.Bt + (size_t)cur.pn * tstep;
    S.a_ready(cur);
    PG8_STAGE(PG8_SB(0, 0), cB, voffB); PG8_STAGE(PG8_SA(0, 0), cA, voffA); PG8_STAGE(PG8_SB(0, 1), cB + hstep, voffB); PG8_STAGE(PG8_SA(0, 1), cA + hstep, voffA);
    if (wr == 1) PG8_BAR;
    PG8_WAIT_V(4); PG8_BAR;
    PG8_STAGE(PG8_SB(1, 0), cB + kstep, voffB); PG8_STAGE(PG8_SA(1, 0), cA + kstep, voffA); PG8_STAGE(PG8_SB(1, 1), cB + hstep + kstep, voffB);
    PG8_WAIT_V(6); PG8_BAR;
    PG8_STAMP();
    for (;;) {
        const bool has_next = S.next(ui + 1, nxt);
        const char* nA = has_next ? (const char*)g.A + (size_t)nxt.pm * tstep : cA; const char* nB = has_next ? (const char*)g.Bt + (size_t)nxt.pn * tstep : cB;
        for (int t = 0; t < nt; t += 2) {
            const bool last = (t == nt - 2);
            const char* a1 = cA + (size_t)(t + 1) * kstep;
            const char* a2 = last ? nA : cA + (size_t)(t + 2) * kstep; const char* b2 = last ? nB : cB + (size_t)(t + 2) * kstep;
            const char* a3 = a2 + kstep; const char* b3 = b2 + kstep;
            if (last && has_next) S.a_ready(nxt);
            PG8_LDB(B0, 0, 0); PG8_SCHED; PG8_LDA(At, 0, 0); PG8_STAGE(PG8_SA(1, 1), a1 + hstep, voffA);
            PG8_WAIT_L(8); PG8_BAR; PG8_WAIT_L(0); PG8_MMA(0, 0, At, B0); PG8_BAR; PG8_SCHED;
            PG8_LDB(B1, 0, 1); PG8_STAGE(PG8_SB(0, 0), b2, voffB);
            PG8_BAR; PG8_WAIT_L(0); PG8_MMA(0, 1, At, B1); PG8_BAR;
            PG8_LDA(At, 0, 1); PG8_STAGE(PG8_SA(0, 0), a2, voffA);
            PG8_BAR; PG8_WAIT_L(0); PG8_MMA(1, 0, At, B0); PG8_BAR; PG8_SCHED;
            PG8_STAGE(PG8_SB(0, 1), b2 + hstep, voffB);
            PG8_WAIT_V(6); PG8_BAR; PG8_MMA(1, 1, At, B1); PG8_BAR;
            PG8_LDB(B0, 1, 0); PG8_SCHED; PG8_LDA(At, 1, 0); PG8_STAGE(PG8_SA(0, 1), a2 + hstep, voffA);
            PG8_WAIT_L(8); PG8_BAR; PG8_WAIT_L(0); PG8_MMA(0, 0, At, B0); PG8_BAR; PG8_SCHED;
            PG8_LDB(B1, 1, 1); PG8_STAGE(PG8_SB(1, 0), b3, voffB);
            PG8_BAR; PG8_WAIT_L(0); PG8_MMA(0, 1, At, B1); PG8_BAR;
            PG8_LDA(At, 1, 1); PG8_STAGE(PG8_SA(1, 0), a3, voffA);
            PG8_BAR; PG8_WAIT_L(0); PG8_MMA(1, 0, At, B0); PG8_BAR; PG8_SCHED;
            PG8_STAGE(PG8_SB(1, 1), b3 + hstep, voffB);
            PG8_WAIT_V(6); PG8_BAR; PG8_MMA(1, 1, At, B1); PG8_BAR;
        }
        PG8_STAMP();
        if constexpr (!Epi::AFTER_DRAIN) { E(acc, cur, wr, wc, fr, fq); S.done(cur); }
        PG8_STAMP();
        if (!has_next) break;
#pragma unroll
        for (int a = 0; a < 2; ++a)
#pragma unroll
            for (int b = 0; b < 2; ++b)
#pragma unroll
                for (int m = 0; m < 4; ++m)
#pragma unroll
                    for (int n = 0; n < 2; ++n) acc[a][b][m][n] = (f32x4){0.f, 0.f, 0.f, 0.f};
        cur = nxt; cA = nA; cB = nB; ++ui;
    }
    PG8_WAIT_V(0);
    if (wr == 0) PG8_BAR;
    PG8_BAR;
    if constexpr (Epi::AFTER_DRAIN) { E.fused(acc, cur, wr, wc, fr, fq, lds, wid, lane); S.done(cur); }
    PG8_STAMP();
    if (STAMP && wid == 0) { stamps[lane] = lane < nts ? (((unsigned long long)(unsigned)ts_hi << 32) | (unsigned)ts_lo) : 0ull;
        if (lane == 62) stamps[62] = rt_entry; if (lane == 63) stamps[63] = (unsigned long long)wall_clock64(); }
#undef PG8_STAMP
#undef PG8_SA
#undef PG8_SB
#undef PG8_STAGE
#undef PG8_LDA
#undef PG8_LDB
#undef PG8_MMA
#undef PG8_WAIT_V
#undef PG8_WAIT_L
#undef PG8_BAR
#undef PG8_SCHED
}
}
using namespace pg8;
#define DIAG_F32TAB 1
typedef unsigned u32x2 __attribute__((ext_vector_type(2)));
typedef __bf16 bf2_t __attribute__((ext_vector_type(2)));

constexpr int NTOK = 32768, SEQL = 8192, DM = 1024;
constexpr size_t MIB = 1ull << 20;
constexpr size_t OFF_WIN = 0, OFF_WBR = 11 * MIB, OFF_WOUT = 13 * MIB, OFF_WC = 15 * MIB, OFF_LORA = 19 * MIB,
                 OFF_ADA = 19 * MIB + 512 * 1024, OFF_KMEAN = 19 * MIB + 640 * 1024, OFF_HBF = 20 * MIB, OFF_PR = 84 * MIB,
                 OFF_PM = 212 * MIB, OFF_PG = 308 * MIB, OFF_FREE = 436 * MIB;
constexpr int LDS_BYTES = 147456;

struct Params {
    const float *x, *c, *w_ada, *b_ada, *norm1_g, *w_in, *mu, *w0, *w2_decay, *a0, *a2_iclr, *g2_gate, *k_k, *k_a, *r_k, *lnx_w, *lnx_b,
                *q_norm_g, *k_norm_g, *w_branch, *w_out, *norm2_g, *w_peer_q, *sub_keys, *peer_u, *peer_v;
    float* out; unsigned char* ws;
};

__constant__ unsigned char cand_tab[64] = {
    0x00,0x01,0x02,0x03,0x04,0x05,0x06,0x07,0x08,0x09,0x0a,0x0b,0x0c,0x0d,0x0e,0x0f,
    0x10,0x11,0x12,0x13,0x14,0x15,0x16,0x17,
    0x20,0x21,0x22,0x23,0x24,
    0x30,0x31,0x32,0x33,
    0x40,0x41,0x42,
    0x50,0x51, 0x60,0x61, 0x70,0x71,
    0x80,0x90,0xa0,0xb0,0xc0,0xd0,0xe0,0xf0,
    0xff,0xff,0xff,0xff,0xff,0xff,0xff,0xff,0xff,0xff,0xff,0xff,0xff,0xff};

__device__ __forceinline__ float bflo(unsigned u) { return __uint_as_float(u << 16); }
__device__ __forceinline__ float bfhi(unsigned u) { return __uint_as_float(u & 0xffff0000u); }
__device__ __forceinline__ float sigmoidf_(float x) { return 1.0f / (1.0f + __expf(-x)); }
template <int CTRL, int RM = 0xF>
__device__ __forceinline__ float dppf(float x) { return __int_as_float(__builtin_amdgcn_update_dpp(__float_as_int(x), __float_as_int(x), CTRL, RM, 0xF, false)); }
template <int CTRL>
__device__ __forceinline__ float dppf0(float x) { return __int_as_float(__builtin_amdgcn_update_dpp(0, __float_as_int(x), CTRL, 0xF, 0xF, false)); }
__device__ __forceinline__ float row_sum16(float x) { x += dppf0<0xB1>(x); x += dppf0<0x4E>(x); x += dppf0<0x141>(x); x += dppf0<0x140>(x); return x; }
__device__ __forceinline__ float wave_max(float x) {
    x = fmaxf(x, dppf<0xB1>(x)); x = fmaxf(x, dppf<0x4E>(x)); x = fmaxf(x, dppf<0x141>(x)); x = fmaxf(x, dppf<0x140>(x));
    x = fmaxf(x, __shfl_xor(x, 16)); x = fmaxf(x, __shfl_xor(x, 32));
    return __int_as_float(__builtin_amdgcn_readfirstlane(__float_as_int(x)));
}
__device__ __forceinline__ void unpack8(const u32x4 v, float (&f)[8]) {
    f[0] = bflo(v.x); f[1] = bfhi(v.x); f[2] = bflo(v.y); f[3] = bfhi(v.y); f[4] = bflo(v.z); f[5] = bfhi(v.z); f[6] = bflo(v.w); f[7] = bfhi(v.w);
}
__device__ __forceinline__ u32x4 pack8(const float (&f)[8]) {
    u32x4 o; o.x = cvt_pk_bf16(f[0], f[1]); o.y = cvt_pk_bf16(f[2], f[3]); o.z = cvt_pk_bf16(f[4], f[5]); o.w = cvt_pk_bf16(f[6], f[7]); return o;
}

struct EpiProj {
    static constexpr bool PERM = true, AFTER_DRAIN = false;
    bf16_t *pr, *pm, *pg;
    __device__ __forceinline__ void operator()(const f32x4 (&acc)[2][2][4][2], const Unit& u, int wr, int wc, int fr, int fq) const {
        const int row0 = u.pm * BM + wr * 64 + fr; bf16_t* base; int ldc, colt; bool sig = false;
        if (u.pn < 8) { base = pr; ldc = 2048; colt = u.pn * 256; } else if (u.pn < 14) { base = pm; ldc = 1536; colt = (u.pn - 8) * 256; } else { base = pg; ldc = 2048; colt = (u.pn - 14) * 256; sig = true; }
        const int col0 = colt + wc * 32 + 8 * fq;
#pragma unroll
        for (int ai = 0; ai < 2; ++ai)
#pragma unroll
            for (int m = 0; m < 4; ++m) { bf16_t* rowp = base + (size_t)(row0 + ai * HALF + m * 16) * ldc + col0;
#pragma unroll
                for (int bj = 0; bj < 2; ++bj) { f32x4 v0 = acc[ai][bj][m][0], v1 = acc[ai][bj][m][1];
                    if (sig) {
#pragma unroll
                        for (int j = 0; j < 4; ++j) { v0[j] = sigmoidf_(v0[j]); v1[j] = sigmoidf_(v1[j]); } }
                    u32x4 w; w.x = cvt_pk_bf16(v0[0], v0[1]); w.y = cvt_pk_bf16(v0[2], v0[3]); w.z = cvt_pk_bf16(v1[0], v1[1]); w.w = cvt_pk_bf16(v1[2], v1[3]);
                    *(u32x4*)(rowp + bj * HALF) = w; } }
    }
};
template <int WHICH> struct EpiMerge {
    static constexpr bool PERM = true, AFTER_DRAIN = false;
    const bf16_t* gates; bf16_t* t0; bf16_t* mix;
    __device__ __forceinline__ void operator()(const f32x4 (&acc)[2][2][4][2], const Unit& u, int wr, int wc, int fr, int fq) const {
        const int row0 = u.pm * BM + wr * 64 + fr, col0 = u.pn * BM + wc * 32 + 8 * fq;
#pragma unroll
        for (int ai = 0; ai < 2; ++ai)
#pragma unroll
            for (int m = 0; m < 4; ++m) { const size_t row = (size_t)(row0 + ai * HALF + m * 16);
#pragma unroll
                for (int bj = 0; bj < 2; ++bj) { const int c = col0 + bj * HALF;
                    const u32x4 gv = *(const u32x4*)(gates + row * 2048 + WHICH * 1024 + c); float g[8]; unpack8(gv, g);
                    const f32x4 v0 = acc[ai][bj][m][0], v1 = acc[ai][bj][m][1]; float r[8];
#pragma unroll
                    for (int j = 0; j < 4; ++j) { r[j] = g[j] * v0[j]; r[4 + j] = g[4 + j] * v1[j]; }
                    if (WHICH == 1) { const u32x4 tv = *(const u32x4*)(t0 + row * 1024 + c); float t[8]; unpack8(tv, t);
#pragma unroll
                        for (int j = 0; j < 8; ++j) r[j] += t[j];
                        *(u32x4*)(mix + row * 1024 + c) = pack8(r); }
                    else *(u32x4*)(t0 + row * 1024 + c) = pack8(r); } }
    }
};
struct EpiOut {
    static constexpr bool PERM = false, AFTER_DRAIN = false;
    const float* x; const float* ada; float* out;
    __device__ __forceinline__ void operator()(const f32x4 (&acc)[2][2][4][2], const Unit& u, int wr, int wc, int fr, int fq) const {
        const int row0 = u.pm * BM + wr * 64 + fr, col0 = u.pn * BM + wc * 32 + 4 * fq; const int b = (u.pm * BM) / SEQL;
        f32x4 gv[2][2];
#pragma unroll
        for (int bj = 0; bj < 2; ++bj)
#pragma unroll
            for (int n = 0; n < 2; ++n) gv[bj][n] = *(const f32x4*)(ada + b * 6144 + 2048 + col0 + bj * HALF + n * 16);
#pragma unroll
        for (int ai = 0; ai < 2; ++ai)
#pragma unroll
            for (int m = 0; m < 4; ++m) { const size_t off = (size_t)(row0 + ai * HALF + m * 16) * DM + col0;
#pragma unroll
                for (int bj = 0; bj < 2; ++bj)
#pragma unroll
                    for (int n = 0; n < 2; ++n) { const f32x4 xv = *(const f32x4*)(x + off + bj * HALF + n * 16);
                        *(f32x4*)(out + off + bj * HALF + n * 16) = xv + gv[bj][n] * acc[ai][bj][m][n]; } }
    }
};
struct EpiScore {
    static constexpr bool PERM = true, AFTER_DRAIN = false;
    bf16_t* O;
    __device__ __forceinline__ void operator()(const f32x4 (&acc)[2][2][4][2], const Unit& u, int wr, int wc, int fr, int fq) const {
        const int row0 = u.pm * BM + wr * 64 + fr, col0 = u.pn * BM + wc * 32 + 8 * fq;
#pragma unroll
        for (int ai = 0; ai < 2; ++ai)
#pragma unroll
            for (int m = 0; m < 4; ++m) { bf16_t* rowp = O + (size_t)(row0 + ai * HALF + m * 16) * 2048 + col0;
#pragma unroll
                for (int bj = 0; bj < 2; ++bj) { const f32x4 v0 = acc[ai][bj][m][0], v1 = acc[ai][bj][m][1];
                    u32x4 w; w.x = cvt_pk_bf16(v0[0], v0[1]); w.y = cvt_pk_bf16(v0[2], v0[3]); w.z = cvt_pk_bf16(v1[0], v1[1]); w.w = cvt_pk_bf16(v1[2], v1[3]);
                    *(u32x4*)(rowp + bj * HALF) = w; } }
    }
};

template <int MODE>
__device__ __forceinline__ void transpose_bf16(const float* __restrict__ W, int K, int Nsrc, bf16_t* __restrict__ Bt, int Nout, size_t gtid, size_t gstride) {
    const size_t total = (size_t)Nout * (K / 8);
    for (size_t it = gtid; it < total; it += gstride) {
        const int n = (int)(it % Nout), k8 = (int)(it / Nout);
        int src = n; if (MODE == 1) src = n < 1824 ? n : (n < 2048 ? -1 : n - 224);
        u32x4 o = {0u, 0u, 0u, 0u};
        if (src >= 0) { const float* p = W + (size_t)(k8 * 8) * Nsrc + src; float v[8];
#pragma unroll
            for (int j = 0; j < 8; ++j) v[j] = p[(size_t)j * Nsrc];
            o = pack8(v); }
        *(u32x4*)(Bt + (size_t)n * K + k8 * 8) = o;
    }
}

__device__ void phase0(const Params& P, unsigned char* smem) {
    const int tid = threadIdx.x, wid = tid >> 6, lane = tid & 63;
    const size_t gtid = (size_t)blockIdx.x * 512 + tid, gstride = (size_t)gridDim.x * 512;
    unsigned char* ws = P.ws;
    transpose_bf16<1>(P.w_in, 1024, 5408, (bf16_t*)(ws + OFF_WIN), 5632, gtid, gstride);
    transpose_bf16<0>(P.w_branch, 512, 1024, (bf16_t*)(ws + OFF_WBR), 1024, gtid, gstride);
    transpose_bf16<0>(P.w_branch + 512 * 1024, 512, 1024, (bf16_t*)(ws + OFF_WBR) + 1024 * 512, 1024, gtid, gstride);
    transpose_bf16<0>(P.w_out, 1024, 1024, (bf16_t*)(ws + OFF_WOUT), 1024, gtid, gstride);
    transpose_bf16<0>(P.w2_decay, 64, 512, (bf16_t*)(ws + OFF_LORA), 512, gtid, gstride);
    transpose_bf16<0>(P.a2_iclr, 64, 512, (bf16_t*)(ws + OFF_LORA) + 512 * 64, 512, gtid, gstride);
    transpose_bf16<0>(P.g2_gate, 160, 512, (bf16_t*)(ws + OFF_LORA) + 2 * 512 * 64, 512, gtid, gstride);
    float* red = (float*)smem; float* ada = (float*)(ws + OFF_ADA);
    for (int task = blockIdx.x; task < 96; task += gridDim.x) {
        const int col = task * 64 + lane; float a0 = 0.f, a1 = 0.f, a2 = 0.f, a3 = 0.f;
        for (int kk = 0; kk < 128; ++kk) { const int k = wid * 128 + kk; const float wv = P.w_ada[(size_t)k * 6144 + col];
            const float c0 = P.c[k], c1 = P.c[1024 + k], c2 = P.c[2048 + k], c3 = P.c[3072 + k];
            a0 += c0 * sigmoidf_(c0) * wv; a1 += c1 * sigmoidf_(c1) * wv; a2 += c2 * sigmoidf_(c2) * wv; a3 += c3 * sigmoidf_(c3) * wv; }
        red[(wid * 4 + 0) * 64 + lane] = a0; red[(wid * 4 + 1) * 64 + lane] = a1; red[(wid * 4 + 2) * 64 + lane] = a2; red[(wid * 4 + 3) * 64 + lane] = a3;
        __syncthreads();
        if (tid < 256) { const int b = tid >> 6, l = tid & 63; float s = P.b_ada[task * 64 + l];
            for (int w = 0; w < 8; ++w) s += red[(w * 4 + b) * 64 + l];
            ada[b * 6144 + task * 64 + l] = s; }
        __syncthreads();
    }
    float* WqS = (float*)smem; float* KgT = (float*)(smem + 32768); bf16_t* WcT = (bf16_t*)(ws + OFF_WC);
    for (int task = blockIdx.x; task < 256; task += gridDim.x) {
        const int g = task >> 4, kt = task & 15, h = g >> 1, half = g & 1;
#pragma unroll
        for (int i = 0; i < 4; ++i) { const int idx = tid + i * 512, r = idx >> 5, d4 = idx & 31;
            *(f32x4*)(WqS + r * 128 + d4 * 4) = *(const f32x4*)(P.w_peer_q + (size_t)(kt * 64 + r) * 2048 + h * 256 + half * 128 + d4 * 4); }
#pragma unroll
        for (int i = 0; i < 8; ++i) { const int idx = tid + i * 512, key = idx >> 5, d4 = idx & 31;
            const f32x4 v = *(const f32x4*)(P.sub_keys + ((size_t)((half * 8 + h) * 128 + key)) * 128 + d4 * 4);
            KgT[(d4 * 4 + 0) * 129 + key] = v[0]; KgT[(d4 * 4 + 1) * 129 + key] = v[1]; KgT[(d4 * 4 + 2) * 129 + key] = v[2]; KgT[(d4 * 4 + 3) * 129 + key] = v[3]; }
        __syncthreads();
        const int key = tid & 127, kq = tid >> 7; float acc[16];
#pragma unroll
        for (int i = 0; i < 16; ++i) acc[i] = 0.f;
        for (int d4 = 0; d4 < 32; ++d4) {
            const float k0 = KgT[(d4 * 4 + 0) * 129 + key], k1 = KgT[(d4 * 4 + 1) * 129 + key], k2 = KgT[(d4 * 4 + 2) * 129 + key], k3 = KgT[(d4 * 4 + 3) * 129 + key];
#pragma unroll
            for (int i = 0; i < 16; ++i) { const f32x4 w4 = *(const f32x4*)(WqS + (kq * 16 + i) * 128 + d4 * 4); acc[i] += w4[0] * k0 + w4[1] * k1 + w4[2] * k2 + w4[3] * k3; }
        }
        bf16_t* dst = WcT + (size_t)(g * 128 + key) * 1024 + kt * 64 + kq * 16;
        u32x4 o0, o1; o0.x = cvt_pk_bf16(acc[0], acc[1]); o0.y = cvt_pk_bf16(acc[2], acc[3]); o0.z = cvt_pk_bf16(acc[4], acc[5]); o0.w = cvt_pk_bf16(acc[6], acc[7]);
        o1.x = cvt_pk_bf16(acc[8], acc[9]); o1.y = cvt_pk_bf16(acc[10], acc[11]); o1.z = cvt_pk_bf16(acc[12], acc[13]); o1.w = cvt_pk_bf16(acc[14], acc[15]);
        *(u32x4*)dst = o0; *(u32x4*)(dst + 8) = o1;
        __syncthreads();
    }
}

__device__ void phase_norm(const float* __restrict__ X, const float* __restrict__ gain, const float* __restrict__ ada, int shift_off, int scale_off, bf16_t* __restrict__ H) {
    const int lane = threadIdx.x & 63, gw = blockIdx.x * 8 + (threadIdx.x >> 6), nw = gridDim.x * 8;
    for (int row = gw; row < NTOK; row += nw) {
        const int b = row / SEQL; const float* xr = X + (size_t)row * DM; f32x4 v[4]; float ss = 0.f;
#pragma unroll
        for (int i = 0; i < 4; ++i) { v[i] = *(const f32x4*)(xr + i * 256 + lane * 4); ss += v[i][0] * v[i][0] + v[i][1] * v[i][1] + v[i][2] * v[i][2] + v[i][3] * v[i][3]; }
        ss += __shfl_xor(ss, 1); ss += __shfl_xor(ss, 2); ss += __shfl_xor(ss, 4); ss += __shfl_xor(ss, 8); ss += __shfl_xor(ss, 16); ss += __shfl_xor(ss, 32);
        const float rinv = rsqrtf(ss * (1.0f / 1024.0f) + 1e-6f);
#pragma unroll
        for (int i = 0; i < 4; ++i) { const int c = i * 256 + lane * 4; const f32x4 g = *(const f32x4*)(gain + c), sh = *(const f32x4*)(ada + b * 6144 + shift_off + c), sc = *(const f32x4*)(ada + b * 6144 + scale_off + c);
            const f32x4 h = v[i] * rinv * g * (sc + 1.0f) + sh; u32x2 o; o.x = cvt_pk_bf16(h[0], h[1]); o.y = cvt_pk_bf16(h[2], h[3]);
            *(u32x2*)(H + (size_t)row * DM + c) = o; }
    }
}

struct ScanBufs { bf16_t *sr, *sw, *sk, *sv, *skk, *sb, *g1, *g2; };
__device__ __forceinline__ float lerp_bf(unsigned short p, unsigned short pp, float mu) { const float a = __uint_as_float((unsigned)p << 16), b = __uint_as_float((unsigned)pp << 16); return a + (b - a) * mu; }
__device__ void phase_rwkv_prep(const Params& P, const ScanBufs& S) {
    const int lane = threadIdx.x & 63, gw = blockIdx.x * 8 + (threadIdx.x >> 6), nw = gridDim.x * 8, fr = lane & 15, fq = lane >> 4;
    const bf16_t* projR = (const bf16_t*)(P.ws + OFF_PR); const bf16_t* w2t = (const bf16_t*)(P.ws + OFF_LORA); const bf16_t* a2t = w2t + 512 * 64; const bf16_t* g2t = w2t + 2 * 512 * 64;
#pragma unroll 1
    for (int tt = gw; tt < NTOK / 16; tt += nw) {
        const int t = tt * 16 + fr, b = t / SEQL, s = t - b * SEQL; const bool hp = (s != 0);
        const bf16_t* prow = projR + (size_t)t * 2048; const bf16_t* pprev = prow - 2048;
        bf16x8 tok[9];
#pragma unroll
        for (int kb = 0; kb < 9; ++kb) { const int c = 1536 + kb * 32 + fq * 8; const u32x4 pv = *(const u32x4*)(prow + c); u32x4 qv = {0u, 0u, 0u, 0u}; if (hp) qv = *(const u32x4*)(pprev + c);
            float a[8], q[8]; unpack8(pv, a); unpack8(qv, q); const f32x4 m0 = *(const f32x4*)(P.mu + c), m1 = *(const f32x4*)(P.mu + c + 4);
#pragma unroll
            for (int j = 0; j < 8; ++j) { const float mu = j < 4 ? m0[j] : m1[j - 4]; float xm = a[j] + (q[j] - a[j]) * mu;
                if (kb < 2) xm = 1.0f - 2.0f / (__expf(2.0f * xm) + 1.0f); else if (kb >= 4) xm = sigmoidf_(xm);
                a[j] = xm; }
            const u32x4 pk = pack8(a); tok[kb] = __builtin_bit_cast(bf16x8, pk); }
#pragma unroll 1
        for (int h = 0; h < 8; ++h) {
            f32x4 accw[4], acca[4], accg[4];
#pragma unroll
            for (int n = 0; n < 4; ++n) { const int oc = h * 64 + n * 16 + fr; accw[n] = (f32x4){0.f, 0.f, 0.f, 0.f}; acca[n] = accw[n]; accg[n] = accw[n];
#pragma unroll
                for (int kb = 0; kb < 2; ++kb) { const bf16x8 wf = *(const bf16x8*)(w2t + oc * 64 + kb * 32 + fq * 8); accw[n] = __builtin_amdgcn_mfma_f32_16x16x32_bf16(wf, tok[kb], accw[n], 0, 0, 0); }
#pragma unroll
                for (int kb = 0; kb < 2; ++kb) { const bf16x8 wf = *(const bf16x8*)(a2t + oc * 64 + kb * 32 + fq * 8); acca[n] = __builtin_amdgcn_mfma_f32_16x16x32_bf16(wf, tok[2 + kb], acca[n], 0, 0, 0); }
#pragma unroll
                for (int kb = 0; kb < 5; ++kb) { const bf16x8 wf = *(const bf16x8*)(g2t + oc * 160 + kb * 32 + fq * 8); accg[n] = __builtin_amdgcn_mfma_f32_16x16x32_bf16(wf, tok[4 + kb], accg[n], 0, 0, 0); }
                asm volatile("" ::: "memory"); }
            const size_t obase = ((size_t)(b * 8 + h) * SEQL + s) * 64;
            float ss = 0.f, bon = 0.f;
#pragma unroll
            for (int n = 0; n < 4; ++n) { const int c0 = h * 64 + n * 16 + fq * 4;
                const u32x2 k2 = *(const u32x2*)(prow + 512 + c0); u32x2 kp = {0u, 0u}; if (hp) kp = *(const u32x2*)(pprev + 512 + c0);
                const f32x4 muk = *(const f32x4*)(P.mu + 512 + c0), kkp = *(const f32x4*)(P.k_k + c0);
                const float k0 = bflo(k2.x), k1 = bfhi(k2.x), k2_ = bflo(k2.y), k3 = bfhi(k2.y), q0 = bflo(kp.x), q1 = bfhi(kp.x), q2 = bflo(kp.y), q3 = bfhi(kp.y);
                const float e0 = (k0 + (q0 - k0) * muk[0]) * kkp[0], e1 = (k1 + (q1 - k1) * muk[1]) * kkp[1], e2 = (k2_ + (q2 - k2_) * muk[2]) * kkp[2], e3 = (k3 + (q3 - k3) * muk[3]) * kkp[3];
                ss += e0 * e0 + e1 * e1 + e2 * e2 + e3 * e3; }
            ss += __shfl_xor(ss, 16); ss += __shfl_xor(ss, 32);
            const float inv = 1.0f / fmaxf(sqrtf(ss), 1e-12f);
            asm volatile("" ::: "memory");
#pragma unroll
            for (int n = 0; n < 4; ++n) { const int c0 = h * 64 + n * 16 + fq * 4;
                const u32x2 r2 = *(const u32x2*)(prow + c0), k2 = *(const u32x2*)(prow + 512 + c0);
                u32x2 rp = {0u, 0u}, kp = {0u, 0u}; if (hp) { rp = *(const u32x2*)(pprev + c0); kp = *(const u32x2*)(pprev + 512 + c0); }
                const f32x4 mur = *(const f32x4*)(P.mu + c0), muk = *(const f32x4*)(P.mu + 512 + c0);
                const f32x4 w0v = *(const f32x4*)(P.w0 + c0), a0v = *(const f32x4*)(P.a0 + c0), kkp = *(const f32x4*)(P.k_k + c0), kap = *(const f32x4*)(P.k_a + c0), rkp = *(const f32x4*)(P.r_k + c0), lw = *(const f32x4*)(P.lnx_w + c0);
                float rr[4], kn[4], om[4], kk[4], bb[4], g1[4];
#pragma unroll
                for (int j = 0; j < 4; ++j) {
                    const unsigned rw = j < 2 ? r2.x : r2.y, rpw = j < 2 ? rp.x : rp.y, kw = j < 2 ? k2.x : k2.y, kpw = j < 2 ? kp.x : kp.y;
                    const float r_ = (j & 1) ? bfhi(rw) : bflo(rw), rp_ = (j & 1) ? bfhi(rpw) : bflo(rpw), k_ = (j & 1) ? bfhi(kw) : bflo(kw), kp_ = (j & 1) ? bfhi(kpw) : bflo(kpw);
                    const float r = r_ + (rp_ - r_) * mur[j], k = k_ + (kp_ - k_) * muk[j];
                    const float wl = w0v[j] + accw[n][j]; const float z = -wl; const float sp = fmaxf(z, 0.f) + __logf(1.0f + __expf(-fabsf(z)));
                    const float e = __expf(-sp - 0.5f); om[j] = 1.0f - __expf(-e);
                    const float a = sigmoidf_(a0v[j] + acca[n][j]);
                    kk[j] = k * kkp[j] * inv; bb[j] = kk[j] * a;
                    kn[j] = k * (1.0f + (a - 1.0f) * kap[j]); rr[j] = r; bon += r * kn[j] * rkp[j]; g1[j] = lw[j] * accg[n][j];
                }
                u32x2 o; o.x = cvt_pk_bf16(rr[0], rr[1]); o.y = cvt_pk_bf16(rr[2], rr[3]); *(u32x2*)(S.sr + obase + n * 16 + fq * 4) = o;
                o.x = cvt_pk_bf16(om[0], om[1]); o.y = cvt_pk_bf16(om[2], om[3]); *(u32x2*)(S.sw + obase + n * 16 + fq * 4) = o;
                o.x = cvt_pk_bf16(kn[0], kn[1]); o.y = cvt_pk_bf16(kn[2], kn[3]); *(u32x2*)(S.sk + obase + n * 16 + fq * 4) = o;
                o.x = cvt_pk_bf16(kk[0], kk[1]); o.y = cvt_pk_bf16(kk[2], kk[3]); *(u32x2*)(S.skk + obase + n * 16 + fq * 4) = o;
                o.x = cvt_pk_bf16(bb[0], bb[1]); o.y = cvt_pk_bf16(bb[2], bb[3]); *(u32x2*)(S.sb + obase + n * 16 + fq * 4) = o;
                o.x = cvt_pk_bf16(g1[0], g1[1]); o.y = cvt_pk_bf16(g1[2], g1[3]); *(u32x2*)(S.g1 + obase + n * 16 + fq * 4) = o;
                asm volatile("" ::: "memory");
            }
            bon += __shfl_xor(bon, 16); bon += __shfl_xor(bon, 32);
#pragma unroll
            for (int n = 0; n < 4; ++n) { const int c0 = h * 64 + n * 16 + fq * 4;
                const u32x2 v2 = *(const u32x2*)(prow + 1024 + c0); u32x2 vp = {0u, 0u}; if (hp) vp = *(const u32x2*)(pprev + 1024 + c0);
                const f32x4 muv = *(const f32x4*)(P.mu + 1024 + c0), lb = *(const f32x4*)(P.lnx_b + c0);
                const float v0 = bflo(v2.x), v1 = bfhi(v2.x), v2_ = bflo(v2.y), v3 = bfhi(v2.y), q0 = bflo(vp.x), q1 = bfhi(vp.x), q2 = bflo(vp.y), q3 = bfhi(vp.y);
                float vv[4]; vv[0] = v0 + (q0 - v0) * muv[0]; vv[1] = v1 + (q1 - v1) * muv[1]; vv[2] = v2_ + (q2 - v2_) * muv[2]; vv[3] = v3 + (q3 - v3) * muv[3];
                float g2[4];
#pragma unroll
                for (int j = 0; j < 4; ++j) g2[j] = (lb[j] + bon * vv[j]) * accg[n][j];
                u32x2 o; o.x = cvt_pk_bf16(vv[0], vv[1]); o.y = cvt_pk_bf16(vv[2], vv[3]); *(u32x2*)(S.sv + obase + n * 16 + fq * 4) = o;
                o.x = cvt_pk_bf16(g2[0], g2[1]); o.y = cvt_pk_bf16(g2[2], g2[3]); *(u32x2*)(S.g2 + obase + n * 16 + fq * 4) = o;
            }
            asm volatile("" ::: "memory");
        }
    }
}

__device__ void phase_moba_prep(const Params& P, unsigned char* smem) {
    const int tid = threadIdx.x; bf16_t* projM = (bf16_t*)(P.ws + OFF_PM); float* kmean = (float*)(P.ws + OFF_KMEAN);
    float* kred = (float*)smem;
    float* part = (float*)(smem + 66560);
    bf16_t* Vs = (bf16_t*)(smem + 66560 + 2048);
    for (int task = blockIdx.x; task < 1024; task += gridDim.x) {
        const int h = task & 7, blk = (task >> 3) & 31, b = task >> 8; const size_t tok0 = (size_t)b * SEQL + blk * 256;
        { const int token = tid & 255, part_ = tid >> 8; bf16_t* ptr = projM + (tok0 + token) * 1536 + part_ * 512 + h * 64; const float* gn = part_ ? P.k_norm_g : P.q_norm_g;
          float x[64]; float ss = 0.f;
#pragma unroll
          for (int i = 0; i < 8; ++i) { const u32x4 v = *(const u32x4*)(ptr + i * 8); float f[8]; unpack8(v, f);
#pragma unroll
              for (int j = 0; j < 8; ++j) { x[i * 8 + j] = f[j]; ss += f[j] * f[j]; } }
          const float rinv = rsqrtf(ss * (1.0f / 64.0f) + 1e-6f) * (part_ ? 1.0f : 0.125f);
#pragma unroll
          for (int i = 0; i < 8; ++i) { float f[8];
#pragma unroll
              for (int j = 0; j < 8; ++j) { f[j] = x[i * 8 + j] * rinv * gn[i * 8 + j]; if (part_) kred[token * 65 + i * 8 + j] = f[j]; }
              *(u32x4*)(ptr + i * 8) = pack8(f); } }
#pragma unroll
        for (int i = 0; i < 4; ++i) { const int c = tid + i * 512, key = c >> 3, d8 = c & 7; const u32x4 v = *(const u32x4*)(projM + (tok0 + key) * 1536 + 1024 + h * 64 + d8 * 8);
            unsigned short* d = (unsigned short*)(Vs + key * 65 + d8 * 8);
            d[0] = (unsigned short)(v.x & 0xffff); d[1] = (unsigned short)(v.x >> 16); d[2] = (unsigned short)(v.y & 0xffff); d[3] = (unsigned short)(v.y >> 16);
            d[4] = (unsigned short)(v.z & 0xffff); d[5] = (unsigned short)(v.z >> 16); d[6] = (unsigned short)(v.w & 0xffff); d[7] = (unsigned short)(v.w >> 16); }
        __syncthreads();
        { const int d = tid & 63, seg = tid >> 6; float s = 0.f; for (int i = 0; i < 32; ++i) s += kred[(seg * 32 + i) * 65 + d]; part[seg * 64 + d] = s; }
#pragma unroll
        for (int i = 0; i < 4; ++i) { const int c = tid + i * 512, d = c >> 5, key8 = c & 31; unsigned short e[8];
#pragma unroll
            for (int j = 0; j < 8; ++j) e[j] = Vs[(key8 * 8 + j) * 65 + d];
            u32x4 o; o.x = e[0] | ((unsigned)e[1] << 16); o.y = e[2] | ((unsigned)e[3] << 16); o.z = e[4] | ((unsigned)e[5] << 16); o.w = e[6] | ((unsigned)e[7] << 16);
            *(u32x4*)(projM + (tok0 + d * 4 + (key8 >> 3)) * 1536 + 1024 + h * 64 + (key8 & 7) * 8) = o; }
        __syncthreads();
        if (tid < 64) { float s = 0.f; for (int w = 0; w < 8; ++w) s += part[w * 64 + tid]; kmean[((size_t)((b * 8 + h) * 32 + blk)) * 64 + tid] = s * (1.0f / 256.0f); }
        __syncthreads();
    }
}

__device__ void phase_scan(const Params& P, const ScanBufs& S, float* __restrict__ Oraw, unsigned char* smem) {
    const int tid = threadIdx.x, wid = tid >> 6, lane = tid & 63, g = lane >> 4, li = lane & 15;
    constexpr int BUFB = 5 * 8192 + 1024;
    for (int task = blockIdx.x; task < 256; task += gridDim.x) {
        const int seq = task >> 3, rowbase = (task & 7) * 8; const size_t sbase = (size_t)seq * SEQL * 64;
        const bf16_t* arr[5] = {S.skk, S.sw, S.sk, S.sb, S.sr};
        u32x2 ld[5]; u32x2 ldv = {0u, 0u};
        auto gload = [&](int c) {
#pragma unroll
            for (int a = 0; a < 5; ++a) ld[a] = *(const u32x2*)(arr[a] + sbase + (size_t)c * 2048 + tid * 4);
            if (tid < 64) ldv = *(const u32x2*)(S.sv + sbase + (size_t)(c * 32 + (tid >> 1)) * 64 + rowbase + (tid & 1) * 4);
        };
        auto lstore = [&](int bufi) { unsigned char* bb = smem + bufi * BUFB;
#pragma unroll
            for (int a = 0; a < 5; ++a) { f32x4 v; v[0] = bflo(ld[a].x); v[1] = bfhi(ld[a].x); v[2] = bflo(ld[a].y); v[3] = bfhi(ld[a].y);
                if (a == 1) { v[0] = 1.0f - v[0]; v[1] = 1.0f - v[1]; v[2] = 1.0f - v[2]; v[3] = 1.0f - v[3]; }
                *(f32x4*)(bb + a * 8192 + tid * 16) = v; }
            if (tid < 64) { f32x4 v; v[0] = bflo(ldv.x); v[1] = bfhi(ldv.x); v[2] = bflo(ldv.y); v[3] = bfhi(ldv.y); *(f32x4*)(bb + 5 * 8192 + tid * 16) = v; }
        };
        gload(0); lstore(0); __syncthreads();
        float s0 = 0.f, s1 = 0.f, s2 = 0.f, s3 = 0.f, ocol = 0.f;
        const int row = rowbase + wid * 4 + g;
        for (int c = 0; c < 256; ++c) {
            if (c + 1 < 256) gload(c + 1);
            if (wid < 2) {
                const unsigned char* bb = smem + (c & 1) * BUFB;
#pragma unroll 4
                for (int st = 0; st < 32; ++st) {
                    const f32x4 kk = *(const f32x4*)(bb + 0 * 8192 + st * 256 + li * 16), w = *(const f32x4*)(bb + 1 * 8192 + st * 256 + li * 16), k = *(const f32x4*)(bb + 2 * 8192 + st * 256 + li * 16),
                                bv = *(const f32x4*)(bb + 3 * 8192 + st * 256 + li * 16), r = *(const f32x4*)(bb + 4 * 8192 + st * 256 + li * 16);
                    const float vv = *(const float*)(bb + 5 * 8192 + st * 32 + (wid * 4 + g) * 4);
                    float p = s0 * kk[0] + s1 * kk[1] + s2 * kk[2] + s3 * kk[3];
                    p = row_sum16(p);
                    s0 = s0 * w[0] + (vv * k[0] - p * bv[0]); s1 = s1 * w[1] + (vv * k[1] - p * bv[1]); s2 = s2 * w[2] + (vv * k[2] - p * bv[2]); s3 = s3 * w[3] + (vv * k[3] - p * bv[3]);
                    float q = s0 * r[0] + s1 * r[1] + s2 * r[2] + s3 * r[3];
                    q = row_sum16(q);
                    ocol = ((st & 15) == li) ? q : ocol;
                    if ((st & 15) == 15) Oraw[((size_t)seq * 64 + row) * SEQL + c * 32 + (st & 16) + li] = ocol;
                }
            }
            if (c + 1 < 256) lstore((c + 1) & 1);
            __syncthreads();
        }
    }
}

__device__ void phase_moba(const Params& P, bf16_t* __restrict__ yb, unsigned char* smem) {
    const int tid = threadIdx.x, wid = tid >> 6, lane = tid & 63, g = lane >> 4, m = lane & 15;
    const bf16_t* projM = (const bf16_t*)(P.ws + OFF_PM); const float* kmean = (const float*)(P.ws + OFF_KMEAN);
    unsigned char* Ks = smem; unsigned char* Vts = smem + 36864; float* acc = (float*)(smem + 70656); float* kmS = (float*)(smem + 137216);
    int* cnt = (int*)(smem + 145408); int* offs = cnt + 32; unsigned short* list = (unsigned short*)(smem + 145728);
    for (int r = 0; r < 4; ++r) {
        const int u = blockIdx.x + r * gridDim.x; if (u >= 1024) break;
        const int bh = u & 31, kg = (u >> 5) & 7, rr = u >> 8;
        const int i = rr == 0 ? 31 - kg : (rr == 1 ? 16 + kg : (rr == 2 ? 15 - kg : kg));
        const int b = bh >> 3, h = bh & 7; const size_t tokb = (size_t)b * SEQL, tok0 = tokb + (size_t)i * 256;
        for (int e = tid; e < 256 * 65; e += 512) acc[e] = 0.f;
        for (int e = tid; e < i * 64; e += 512) kmS[e] = kmean[(size_t)(bh * 32) * 64 + e];
        if (tid < 32) cnt[tid] = 0;
        __syncthreads();
        int selj[3] = {-1, -1, -1}, slot[3] = {0, 0, 0}; const int nsel = i < 3 ? i : 3;
        if (tid < 256 && i > 0) {
            float q[64]; const bf16_t* qp = projM + (tok0 + tid) * 1536 + h * 64;
#pragma unroll
            for (int t8 = 0; t8 < 8; ++t8) { const u32x4 v = *(const u32x4*)(qp + t8 * 8); float f[8]; unpack8(v, f);
#pragma unroll
                for (int j = 0; j < 8; ++j) q[t8 * 8 + j] = f[j]; }
            float b0 = -3e38f, b1 = -3e38f, b2 = -3e38f; int j0 = -1, j1 = -1, j2 = -1;
            for (int j = 0; j < i; ++j) { float d = 0.f;
#pragma unroll
                for (int t4 = 0; t4 < 16; ++t4) { const f32x4 kv = *(const f32x4*)(kmS + j * 64 + t4 * 4); d += q[t4 * 4] * kv[0] + q[t4 * 4 + 1] * kv[1] + q[t4 * 4 + 2] * kv[2] + q[t4 * 4 + 3] * kv[3]; }
                if (d > b0) { b2 = b1; j2 = j1; b1 = b0; j1 = j0; b0 = d; j0 = j; } else if (d > b1) { b2 = b1; j2 = j1; b1 = d; j1 = j; } else if (d > b2) { b2 = d; j2 = j; } }
            selj[0] = j0; selj[1] = j1; selj[2] = j2;
#pragma unroll
            for (int s = 0; s < 3; ++s) if (s < nsel) slot[s] = atomicAdd(&cnt[selj[s]], 1);
        }
        __syncthreads();
        if (tid == 0) { int o = 0; for (int j = 0; j < 32; ++j) { offs[j] = o; o += cnt[j]; } offs[32] = o; }
        __syncthreads();
        if (tid < 256 && i > 0) {
#pragma unroll
            for (int s = 0; s < 3; ++s) if (s < nsel) list[offs[selj[s]] + slot[s]] = (unsigned short)tid;
        }
        __syncthreads();
        for (int j = 0; j <= i; ++j) {
            const bool own = (j == i); const int nq = own ? 256 : cnt[j];
            if (nq == 0) continue;
            __syncthreads();
            const size_t tokj = tokb + (size_t)j * 256;
#pragma unroll
            for (int t4 = 0; t4 < 4; ++t4) { const int c = tid + t4 * 512;
                { const int key = c >> 3, d8 = c & 7; *(u32x4*)(Ks + key * 144 + d8 * 16) = *(const u32x4*)(projM + (tokj + key) * 1536 + 512 + h * 64 + d8 * 8); }
                { const int d = c >> 5, key8 = c & 31; *(u32x4*)(Vts + d * 528 + key8 * 16) = *(const u32x4*)(projM + (tokj + d * 4 + (key8 >> 3)) * 1536 + 1024 + h * 64 + (key8 & 7) * 8); } }
            __syncthreads();
            const int ng = (nq + 15) >> 4, lbase = own ? 0 : offs[j];
            for (int grp = wid; grp < ng; grp += 8) {
                const int qpos = grp * 16 + m; const bool valid = qpos < nq;
                const int qi = own ? qpos : (int)list[lbase + (valid ? qpos : 0)];
                const bf16_t* qp = projM + (tok0 + qi) * 1536 + h * 64 + g * 8;
                const bf16x8 qf0 = *(const bf16x8*)qp, qf1 = *(const bf16x8*)(qp + 32);
                const int nslab = own ? (grp >> 1) + 1 : 8;
                f32x4 o[4]; float dsum = 0.f;
#pragma unroll
                for (int dt = 0; dt < 4; ++dt) o[dt] = (f32x4){0.f, 0.f, 0.f, 0.f};
                for (int sl = 0; sl < nslab; ++sl) {
                    const unsigned char* kb0 = Ks + (sl * 32 + 8 * (m >> 2) + (m & 3)) * 144 + g * 16;
                    f32x4 s0 = (f32x4){0.f, 0.f, 0.f, 0.f}, s1 = s0;
                    s0 = __builtin_amdgcn_mfma_f32_16x16x32_bf16(*(const bf16x8*)(kb0), qf0, s0, 0, 0, 0);
                    s0 = __builtin_amdgcn_mfma_f32_16x16x32_bf16(*(const bf16x8*)(kb0 + 64), qf1, s0, 0, 0, 0);
                    s1 = __builtin_amdgcn_mfma_f32_16x16x32_bf16(*(const bf16x8*)(kb0 + 4 * 144), qf0, s1, 0, 0, 0);
                    s1 = __builtin_amdgcn_mfma_f32_16x16x32_bf16(*(const bf16x8*)(kb0 + 4 * 144 + 64), qf1, s1, 0, 0, 0);
                    float p[8];
#pragma unroll
                    for (int jj = 0; jj < 4; ++jj) { p[jj] = __expf(s0[jj]); p[4 + jj] = __expf(s1[jj]); }
                    if (own) {
#pragma unroll
                        for (int jj = 0; jj < 8; ++jj) if (sl * 32 + 8 * g + jj > qpos) p[jj] = 0.f; }
#pragma unroll
                    for (int jj = 0; jj < 8; ++jj) dsum += p[jj];
                    const u32x4 pk = pack8(p); const bf16x8 pb = __builtin_bit_cast(bf16x8, pk);
#pragma unroll
                    for (int dt = 0; dt < 4; ++dt) o[dt] = __builtin_amdgcn_mfma_f32_16x16x32_bf16(*(const bf16x8*)(Vts + (dt * 16 + m) * 528 + (sl * 32 + g * 8) * 2), pb, o[dt], 0, 0, 0);
                }
                dsum += __shfl_xor(dsum, 16); dsum += __shfl_xor(dsum, 32);
                if (valid) {
#pragma unroll
                    for (int dt = 0; dt < 4; ++dt)
#pragma unroll
                        for (int jj = 0; jj < 4; ++jj) atomicAdd(&acc[qi * 65 + dt * 16 + 4 * g + jj], o[dt][jj]);
                    if (g == 0) atomicAdd(&acc[qi * 65 + 64], dsum);
                }
            }
        }
        __syncthreads();
        { const int q = tid >> 1, hf = tid & 1; const float inv = 1.0f / acc[q * 65 + 64]; bf16_t* dst = yb + (tok0 + q) * 512 + h * 64 + hf * 32;
#pragma unroll
          for (int t8 = 0; t8 < 4; ++t8) { float f[8];
#pragma unroll
              for (int j = 0; j < 8; ++j) f[j] = acc[q * 65 + hf * 32 + t8 * 8 + j] * inv;
              *(u32x4*)(dst + t8 * 8) = pack8(f); } }
        __syncthreads();
    }
}

__device__ void phase_gn(const ScanBufs& S, const float* __restrict__ Oraw, bf16_t* __restrict__ ya) {
    const int lane = threadIdx.x & 63, gw = blockIdx.x * 8 + (threadIdx.x >> 6), nw = gridDim.x * 8;
    for (int task = gw; task < 32 * 128; task += nw) {
        const int seq = task >> 7, s = (task & 127) * 64 + lane, b = seq >> 3, h = seq & 7;
        float o[64]; float mean = 0.f;
#pragma unroll
        for (int v = 0; v < 64; ++v) { o[v] = Oraw[((size_t)seq * 64 + v) * SEQL + s]; mean += o[v]; }
        mean *= (1.0f / 64.0f); float var = 0.f;
#pragma unroll
        for (int v = 0; v < 64; ++v) { const float d = o[v] - mean; var += d * d; }
        const float rstd = rsqrtf(var * (1.0f / 64.0f) + 64e-5f);
        const size_t gb = ((size_t)seq * SEQL + s) * 64; bf16_t* dst = ya + ((size_t)b * SEQL + s) * 512 + h * 64;
#pragma unroll
        for (int t8 = 0; t8 < 8; ++t8) { const u32x4 a = *(const u32x4*)(S.g1 + gb + t8 * 8), c = *(const u32x4*)(S.g2 + gb + t8 * 8); float fa[8], fc[8], f[8]; unpack8(a, fa); unpack8(c, fc);
#pragma unroll
            for (int j = 0; j < 8; ++j) f[j] = (o[t8 * 8 + j] - mean) * rstd * fa[j] + fc[j];
            *(u32x4*)(dst + t8 * 8) = pack8(f); }
    }
}

__device__ void convert_bf16(const float* __restrict__ src, bf16_t* __restrict__ dst, size_t n8) {
    const size_t gtid = (size_t)blockIdx.x * 512 + threadIdx.x, gstride = (size_t)gridDim.x * 512;
    for (size_t i = gtid; i < n8; i += gstride) { const f32x4 a = *(const f32x4*)(src + i * 8), b = *(const f32x4*)(src + i * 8 + 4);
        u32x4 o; o.x = cvt_pk_bf16(a[0], a[1]); o.y = cvt_pk_bf16(a[2], a[3]); o.z = cvt_pk_bf16(b[0], b[1]); o.w = cvt_pk_bf16(b[2], b[3]); *(u32x4*)(dst + i * 8) = o; }
}

__device__ __forceinline__ float gelu_erf(float v) {
    const float av = fabsf(v), t = 1.0f / (1.0f + 0.2316418882f * av);
    float q = t * 0.5307027145f + (-0.7265760135f); q = q * t + 0.7107068705f; q = q * t + (-0.142248368f); q = q * t + 0.127414796f; q = q * t;
    const float e = __expf(-0.5f * v * v); const float mm = v * (q * e); return v < 0.f ? mm : v - mm;
}
__device__ __forceinline__ float dot16(const u32x4 a0, const u32x4 a1, const u32x4 h0, const u32x4 h1) {
    float s = 0.f;
    s = __builtin_amdgcn_fdot2_f32_bf16(__builtin_bit_cast(bf2_t, a0.x), __builtin_bit_cast(bf2_t, h0.x), s, false);
    s = __builtin_amdgcn_fdot2_f32_bf16(__builtin_bit_cast(bf2_t, a0.y), __builtin_bit_cast(bf2_t, h0.y), s, false);
    s = __builtin_amdgcn_fdot2_f32_bf16(__builtin_bit_cast(bf2_t, a0.z), __builtin_bit_cast(bf2_t, h0.z), s, false);
    s = __builtin_amdgcn_fdot2_f32_bf16(__builtin_bit_cast(bf2_t, a0.w), __builtin_bit_cast(bf2_t, h0.w), s, false);
    s = __builtin_amdgcn_fdot2_f32_bf16(__builtin_bit_cast(bf2_t, a1.x), __builtin_bit_cast(bf2_t, h1.x), s, false);
    s = __builtin_amdgcn_fdot2_f32_bf16(__builtin_bit_cast(bf2_t, a1.y), __builtin_bit_cast(bf2_t, h1.y), s, false);
    s = __builtin_amdgcn_fdot2_f32_bf16(__builtin_bit_cast(bf2_t, a1.z), __builtin_bit_cast(bf2_t, h1.z), s, false);
    s = __builtin_amdgcn_fdot2_f32_bf16(__builtin_bit_cast(bf2_t, a1.w), __builtin_bit_cast(bf2_t, h1.w), s, false);
    return s;
}
__device__ __forceinline__ float top16_of_2(float x0, float x1, int li) {
    float sorted = 0.f; const float NEG = -3.0e38f;
#pragma unroll
    for (int r = 0; r < 16; ++r) { const float mx = wave_max(fmaxf(x0, x1));
        const int widx = (int)(__float_as_uint(mx) & 127u), l2 = (int)(threadIdx.x & 63) * 2;
        x0 = (widx == l2) ? NEG : x0; x1 = (widx == l2 + 1) ? NEG : x1;
        sorted = (li == r) ? mx : sorted; }
    return sorted;
}
__device__ __forceinline__ void axpy16(float (&oa)[16], const u32x4 v0, const u32x4 v1, float a) {
    oa[0] += a * bflo(v0.x); oa[1] += a * bfhi(v0.x); oa[2] += a * bflo(v0.y); oa[3] += a * bfhi(v0.y); oa[4] += a * bflo(v0.z); oa[5] += a * bfhi(v0.z); oa[6] += a * bflo(v0.w); oa[7] += a * bfhi(v0.w);
    oa[8] += a * bflo(v1.x); oa[9] += a * bfhi(v1.x); oa[10] += a * bflo(v1.y); oa[11] += a * bfhi(v1.y); oa[12] += a * bflo(v1.z); oa[13] += a * bfhi(v1.z); oa[14] += a * bflo(v1.w); oa[15] += a * bfhi(v1.w);
}
__device__ void phase_peer(const Params& P, const bf16_t* __restrict__ h2, const bf16_t* __restrict__ scores, const bf16_t* __restrict__ U, const bf16_t* __restrict__ V) {
    const int lane = threadIdx.x & 63, li = lane & 15, gw = blockIdx.x * 8 + (threadIdx.x >> 6), nw = gridDim.x * 8;
    const float* ada = (const float*)(P.ws + OFF_ADA);
    const unsigned ct = cand_tab[lane]; const int ca = ct >> 4, cb = ct & 15; const bool cvalid = ct != 0xffu;
    for (int t = gw; t < NTOK; t += nw) {
        const int b = t / SEQL;
        const u32x4 h0 = *(const u32x4*)(h2 + (size_t)t * DM + lane * 8), h1 = *(const u32x4*)(h2 + (size_t)t * DM + 512 + lane * 8);
        float oa[16];
#pragma unroll
        for (int j = 0; j < 16; ++j) oa[j] = 0.f;
        for (int hd = 0; hd < 8; ++hd) {
            const unsigned w1 = *(const unsigned*)(scores + (size_t)t * 2048 + hd * 256 + lane * 2), w2 = *(const unsigned*)(scores + (size_t)t * 2048 + hd * 256 + 128 + lane * 2);
            const float srt1 = top16_of_2(__uint_as_float((w1 << 16) | (unsigned)(lane * 2)), __uint_as_float((w1 & 0xffff0000u) | (unsigned)(lane * 2 + 1)), li);
            const float srt2 = top16_of_2(__uint_as_float((w2 << 16) | (unsigned)(lane * 2)), __uint_as_float((w2 & 0xffff0000u) | (unsigned)(lane * 2 + 1)), li);
            const float va = __shfl(srt1, ca), vb = __shfl(srt2, cb);
            const int eid = (int)((__float_as_uint(va) & 127u) * 128u + (__float_as_uint(vb) & 127u));
            float ck = cvalid ? __uint_as_float((__float_as_uint(va + vb) & ~63u) | (unsigned)lane) : -3.0e38f;
            float wsc = 0.f; int we = 0;
#pragma unroll
            for (int r = 0; r < 16; ++r) { const float mx = wave_max(ck); const int wl = (int)(__float_as_uint(mx) & 63u);
                const int ee = __builtin_amdgcn_readlane(eid, wl);
                ck = (wl == lane) ? -3.0e38f : ck;
                wsc = (li == r) ? mx : wsc; we = (li == r) ? ee : we; }
            const float smax = __int_as_float(__builtin_amdgcn_readlane(__float_as_int(wsc), 0));
            const float ex = __expf(wsc - smax);
#ifdef DIAG_UNIF
            const float gwt = 0.0625f + 0.f * ex;
#else
            const float gwt = ex / row_sum16(ex);
#endif
            float pd[16];
#pragma unroll
            for (int bt = 0; bt < 2; ++bt) { u32x4 ua[8], ub[8];
#pragma unroll
                for (int j = 0; j < 8; ++j) { const int e = __builtin_amdgcn_readlane(we, bt * 8 + j); const bf16_t* up = U + (size_t)e * DM + lane * 8; ua[j] = *(const u32x4*)up; ub[j] = *(const u32x4*)(up + 512); }
#pragma unroll
                for (int j = 0; j < 8; ++j) pd[bt * 8 + j] = dot16(ua[j], ub[j], h0, h1);
#ifdef DIAG_F32TAB
                { float hf[16]; { float t8[8]; unpack8(h0, t8); for (int q = 0; q < 8; ++q) hf[q] = t8[q]; unpack8(h1, t8); for (int q = 0; q < 8; ++q) hf[8 + q] = t8[q]; }
#pragma unroll
                  for (int j = 0; j < 8; ++j) { const int e = __builtin_amdgcn_readlane(we, bt * 8 + j); const float* up = P.peer_u + (size_t)e * DM + lane * 8;
                      const f32x4 a0 = *(const f32x4*)up, a1 = *(const f32x4*)(up + 4), b0 = *(const f32x4*)(up + 512), b1 = *(const f32x4*)(up + 516);
                      pd[bt * 8 + j] = a0[0] * hf[0] + a0[1] * hf[1] + a0[2] * hf[2] + a0[3] * hf[3] + a1[0] * hf[4] + a1[1] * hf[5] + a1[2] * hf[6] + a1[3] * hf[7]
                                     + b0[0] * hf[8] + b0[1] * hf[9] + b0[2] * hf[10] + b0[3] * hf[11] + b1[0] * hf[12] + b1[1] * hf[13] + b1[2] * hf[14] + b1[3] * hf[15]; } }
#endif
            }
#ifdef DIAG_SIMPLE_RED
            float dsum = 0.f;
#pragma unroll
            for (int j = 0; j < 16; ++j) { float sx = pd[j]; sx += __shfl_xor(sx, 1); sx += __shfl_xor(sx, 2); sx += __shfl_xor(sx, 4); sx += __shfl_xor(sx, 8); sx += __shfl_xor(sx, 16); sx += __shfl_xor(sx, 32); dsum = (li == j) ? sx : dsum; }
#else
            float q8[8];
            { const bool hi = (li & 8) != 0;
#pragma unroll
              for (int j = 0; j < 8; ++j) { const float send = hi ? pd[j] : pd[j + 8], keep = hi ? pd[j + 8] : pd[j]; q8[j] = keep + dppf0<0x140>(send); } }
            float q4[4];
            { const bool hi = (li & 4) != 0;
#pragma unroll
              for (int j = 0; j < 4; ++j) { const float send = hi ? q8[j] : q8[j + 4], keep = hi ? q8[j + 4] : q8[j]; q4[j] = keep + dppf0<0x141>(send); } }
            float q2[2];
            { const bool hi = (li & 2) != 0;
#pragma unroll
              for (int j = 0; j < 2; ++j) { const float send = hi ? q4[j] : q4[j + 2], keep = hi ? q4[j + 2] : q4[j]; q2[j] = keep + dppf0<0x1B>(send); } }
            float dsum;
            { const bool hi = (li & 1) != 0; const float send = hi ? q2[0] : q2[1], keep = hi ? q2[1] : q2[0]; dsum = keep + dppf0<0xB1>(send); }
            dsum += __shfl_xor(dsum, 16); dsum += __shfl_xor(dsum, 32);
#endif
#ifdef DIAG_HALF_A
            dsum *= 0.5f;
#endif
            const float act = gelu_erf(dsum) * gwt;
#pragma unroll
            for (int bt = 0; bt < 2; ++bt) { u32x4 va_[8], vb_[8];
#pragma unroll
                for (int j = 0; j < 8; ++j) { const int e = __builtin_amdgcn_readlane(we, bt * 8 + j); const bf16_t* vp = V + (size_t)e * DM + lane * 8; va_[j] = *(const u32x4*)vp; vb_[j] = *(const u32x4*)(vp + 512); }
#pragma unroll
                for (int j = 0; j < 8; ++j) { const float a = __int_as_float(__builtin_amdgcn_readlane(__float_as_int(act), bt * 8 + j));
#ifdef DIAG_F32TAB
                    const int e = __builtin_amdgcn_readlane(we, bt * 8 + j); const float* vp = P.peer_v + (size_t)e * DM + lane * 8;
                    const f32x4 a0 = *(const f32x4*)vp, a1 = *(const f32x4*)(vp + 4), b0 = *(const f32x4*)(vp + 512), b1 = *(const f32x4*)(vp + 516);
#pragma unroll
                    for (int q = 0; q < 4; ++q) { oa[q] += a * a0[q]; oa[4 + q] += a * a1[q]; oa[8 + q] += a * b0[q]; oa[12 + q] += a * b1[q]; }
#else
                    axpy16(oa, va_[j], vb_[j], a);
#endif
                } }
        }
        float* op = P.out + (size_t)t * DM; const float* g2p = ada + b * 6144 + 5120;
#ifdef DIAG_NEG
#pragma unroll
        for (int j = 0; j < 16; ++j) oa[j] = -oa[j];
#endif
#pragma unroll
        for (int hf = 0; hf < 2; ++hf)
#pragma unroll
            for (int q = 0; q < 2; ++q) { const int c = hf * 512 + lane * 8 + q * 4; const f32x4 xv = *(const f32x4*)(op + c), gv = *(const f32x4*)(g2p + c);
                f32x4 r; r[0] = xv[0] + gv[0] * oa[hf * 8 + q * 4 + 0]; r[1] = xv[1] + gv[1] * oa[hf * 8 + q * 4 + 1]; r[2] = xv[2] + gv[2] * oa[hf * 8 + q * 4 + 2]; r[3] = xv[3] + gv[3] * oa[hf * 8 + q * 4 + 3];
                *(f32x4*)(op + c) = r; }
    }
}

__global__ void __launch_bounds__(512) fwd_megakernel(Params P) {
    extern __shared__ __attribute__((aligned(16))) unsigned char smem[];
    cg::grid_group grid = cg::this_grid();
    unsigned char* ws = P.ws; PG8_LAS unsigned char* lds = (PG8_LAS unsigned char*)smem;
    bf16_t* hbf = (bf16_t*)(ws + OFF_HBF); bf16_t* projR = (bf16_t*)(ws + OFF_PR); bf16_t* projM = (bf16_t*)(ws + OFF_PM); bf16_t* projG = (bf16_t*)(ws + OFF_PG);
    float* ada = (float*)(ws + OFF_ADA);
    ScanBufs S; S.sr = hbf; S.sw = hbf + (size_t)NTOK * 512; S.sk = (bf16_t*)(ws + OFF_FREE); S.sv = S.sk + (size_t)NTOK * 512;
    S.skk = (bf16_t*)P.out; S.sb = S.skk + (size_t)NTOK * 512; S.g1 = S.sb + (size_t)NTOK * 512; S.g2 = S.g1 + (size_t)NTOK * 512;
    float* Oraw = (float*)projR; bf16_t* ya = projR + (size_t)NTOK * 1024; bf16_t* yb = ya + (size_t)NTOK * 512; bf16_t* t0 = projR; bf16_t* mix = hbf;
    bf16_t* h2 = projR + (size_t)NTOK * 1024; bf16_t* scores = projG; bf16_t* Ub = projM; bf16_t* Vb = projM + (size_t)16384 * 1024;
    StaticOrder so;

    phase0(P, smem);
    grid.sync();
    phase_norm(P.x, P.norm1_g, ada, 0, 1024, hbf);
    grid.sync();
    { Gemm g{hbf, (const bf16_t*)(ws + OFF_WIN), NTOK, 5632, 1024}; so.init(NTOK, 5632, gridDim.x, blockIdx.x); EpiProj e{projR, projM, projG}; gemm_phase(lds, g, so, e, nullptr); }
    grid.sync();
    phase_rwkv_prep(P, S);
    phase_moba_prep(P, smem);
    grid.sync();
    phase_scan(P, S, Oraw, smem);
    phase_moba(P, yb, smem);
    grid.sync();
    phase_gn(S, Oraw, ya);
    grid.sync();
    { so.init(NTOK, 1024, gridDim.x, blockIdx.x); Gemm ga{ya, (const bf16_t*)(ws + OFF_WBR), NTOK, 1024, 512}; EpiMerge<0> ea{projG, t0, mix}; gemm_phase(lds, ga, so, ea, nullptr); }
    { so.init(NTOK, 1024, gridDim.x, blockIdx.x); Gemm gb{yb, (const bf16_t*)(ws + OFF_WBR) + 1024 * 512, NTOK, 1024, 512}; EpiMerge<1> eb{projG, t0, mix}; gemm_phase(lds, gb, so, eb, nullptr); }
    grid.sync();
    { so.init(NTOK, 1024, gridDim.x, blockIdx.x); Gemm g{mix, (const bf16_t*)(ws + OFF_WOUT), NTOK, 1024, 1024}; EpiOut e{P.x, ada, P.out}; gemm_phase(lds, g, so, e, nullptr); }
    grid.sync();
    phase_norm(P.out, P.norm2_g, ada, 3072, 4096, h2);
    convert_bf16(P.peer_u, Ub, (size_t)16384 * 1024 / 8);
    convert_bf16(P.peer_v, Vb, (size_t)16384 * 1024 / 8);
    grid.sync();
    { so.init(NTOK, 2048, gridDim.x, blockIdx.x); Gemm g{h2, (const bf16_t*)(ws + OFF_WC), NTOK, 2048, 1024}; EpiScore e{scores}; gemm_phase(lds, g, so, e, nullptr); }
    grid.sync();
#ifndef DIAG_NOPEER
    phase_peer(P, h2, scores, Ub, Vb);
#endif
}

extern "C" void kernel_launch(void* const* d_in, const int* in_sizes, int n_in, void* d_out, int out_size, void* d_ws, size_t ws_size, hipStream_t stream) {
    static int grid = 0;
    if (grid == 0) {
        int dev = 0, cus = 0, per_cu = 0;
        hipGetDevice(&dev); hipDeviceGetAttribute(&cus, hipDeviceAttributeMultiprocessorCount, dev);
        hipFuncSetAttribute((const void*)fwd_megakernel, hipFuncAttributeMaxDynamicSharedMemorySize, LDS_BYTES);
        hipOccupancyMaxActiveBlocksPerMultiprocessor(&per_cu, (const void*)fwd_megakernel, 512, LDS_BYTES);
        (void)hipGetLastError();
        if (per_cu < 1) per_cu = 1;
        grid = cus > 0 ? cus : 256;
    }
    Params p{};
    const float** f = (const float**)&p;
    for (int i = 0; i < 26; ++i) f[i] = (const float*)d_in[i];
    p.out = (float*)d_out; p.ws = (unsigned char*)d_ws;
    void* args[] = {&p};
    hipError_t e = hipLaunchCooperativeKernel((const void*)fwd_megakernel, dim3(grid), dim3(512), args, LDS_BYTES, stream);
    if (e != hipSuccess) fprintf(stderr, "cooperative launch failed: %s (grid %d)\n", hipGetErrorString(e), grid);
}
```

```cpp
#include <hip/hip_runtime.h>
#include <hip/hip_cooperative_groups.h>
#include <cstdio>
namespace cg = cooperative_groups;
namespace pg8 {
#define PG8_LAS __attribute__((address_space(3)))
typedef unsigned short bf16_t;
typedef short bf16x8 __attribute__((ext_vector_type(8)));
typedef float f32x4 __attribute__((ext_vector_type(4)));
typedef unsigned u32x4 __attribute__((ext_vector_type(4)));
constexpr int BM = 256, BK = 64, HALF = 128, HTB = HALF * BK * 2  , STAGE_BYTES = 8 * HTB, NXCD = 8, WGM = 8;

__host__ __device__ __forceinline__ int lds_byte(int r, int c) { const int st = (r >> 4) * 2 + (c >> 5), rr = r & 15, cc = c & 31, ob = rr * 64 + cc * 2; return st * 1024 + (ob ^ (((ob >> 9) & 1) << 5)); }
__host__ __device__ __forceinline__ void stage_rc(int b, int& R, int& C) { const int st = b / 1024, sb = b % 1024, swz = sb ^ (((sb >> 9) & 1) << 5); R = (st >> 1) * 16 + swz / 64; C = (st & 1) * 32 + (swz % 64) / 2; }
__host__ __device__ __forceinline__ int perm32(int rho) { const int n = rho >> 4, i = rho & 15; return 8 * (i >> 2) + 4 * n + (i & 3); }

struct Unit { int pm, pn; };
struct Gemm { const bf16_t* A; const bf16_t* Bt; int M, N, K; };

struct StaticOrder {
    int nM, nN, nwg, G, c;
    __host__ __device__ void init(int M, int N, int G_, int c_) { nM = M / BM; nN = N / BM; nwg = nM * nN; G = G_; c = c_; }
    __host__ __device__ bool next(int i, Unit& u) const {
        const long L = (long)i * G + c; if (L >= nwg) return false;
        int wgid = (int)L; { const int q = nwg / NXCD, r = nwg % NXCD, xcd = wgid % NXCD, off = wgid / NXCD; wgid = (xcd < r ? xcd * (q + 1) : r * (q + 1) + (xcd - r) * q) + off; }
        const int nig = WGM * nN, gid = wgid / nig, fm = gid * WGM, gsz = (nM - fm) < WGM ? (nM - fm) : WGM;
        u.pm = fm + ((wgid % nig) % gsz); u.pn = (wgid % nig) / gsz; return true;
    }
    __device__ __forceinline__ void a_ready(const Unit&) const {}
    __device__ __forceinline__ void done(const Unit&) const {}
};
__device__ __forceinline__ unsigned cvt_pk_bf16(float lo, float hi) { unsigned r; asm volatile("v_cvt_pk_bf16_f32 %0, %1, %2" : "=v"(r) : "v"(lo), "v"(hi)); return r; }
typedef float f32x2 __attribute__((ext_vector_type(2)));
template <class Epi, class Sched, bool STAMP = false>
__device__ __forceinline__ void gemm_phase(PG8_LAS unsigned char* lds, const Gemm g, const Sched& S, const Epi& E, unsigned long long* stamps) {
    int tid_ = threadIdx.x; asm volatile("" : "+v"(tid_));
    const int tid = tid_, wid = __builtin_amdgcn_readfirstlane(tid >> 6), lane = tid & 63, wr = wid >> 2, wc = wid & 3, fr = lane & 15, fq = lane >> 4;
    const int K = g.K, nt = K / BK;
    int ts_lo = 0, ts_hi = 0, nts = 0; const unsigned long long rt_entry = STAMP ? (unsigned long long)wall_clock64() : 0ull;
#define PG8_STAMP() do { if (STAMP && wid == 0 && nts < 64) { const unsigned long long _c = (unsigned long long)clock64(); \
        ts_lo = (lane == nts) ? (int)(unsigned)_c : ts_lo; ts_hi = (lane == nts) ? (int)(unsigned)(_c >> 32) : ts_hi; ++nts; } } while (0)
    PG8_STAMP();
    unsigned voffA[2], voffB[2];
#pragma unroll
    for (int i = 0; i < 2; ++i) { int R, C; stage_rc(tid * 16 + i * 8192, R, C); const int Rb = Epi::PERM ? ((R & ~31) + perm32(R & 31)) : R;
        voffA[i] = (unsigned)(R * K + C) * 2u; voffB[i] = (unsigned)(Rb * K + C) * 2u; }
    const size_t kstep = (size_t)(BK * 2);
    const size_t hstep = (size_t)HALF * K * 2;
    const size_t tstep = 2 * hstep;
    const unsigned ldsw = (unsigned)wid * 1024u;
    const int aoff = lds_byte(wr * 64 + fr, fq * 8), boff = lds_byte(wc * 32 + fr, fq * 8);
#define PG8_SA(b, h) (((b) * 2 + (h)) * HTB)
#define PG8_SB(b, h) ((4 + (b) * 2 + (h)) * HTB)
#define PG8_STAGE(bufoff, gbase, voff) do { _Pragma("unroll") for (int _i = 0; _i < 2; ++_i) \
        __builtin_amdgcn_global_load_lds((const unsigned*)((const char*)(gbase) + (voff)[_i]), (PG8_LAS unsigned*)(lds + (bufoff) + ldsw + _i * 8192), 16, 0, 0); } while (0)
#define PG8_LDA(dst, b, h) do { _Pragma("unroll") for (int m = 0; m < 4; ++m) _Pragma("unroll") for (int k = 0; k < 2; ++k) dst[m][k] = *(const PG8_LAS bf16x8*)(lds + PG8_SA(b, h) + aoff + m * 2048 + k * 1024); } while (0)
#define PG8_LDB(dst, b, h) do { _Pragma("unroll") for (int n = 0; n < 2; ++n) _Pragma("unroll") for (int k = 0; k < 2; ++k) dst[n][k] = *(const PG8_LAS bf16x8*)(lds + PG8_SB(b, h) + boff + n * 2048 + k * 1024); } while (0)
#define PG8_MMA(ai, bj, At, Bt) do { __builtin_amdgcn_s_setprio(1); _Pragma("unroll") for (int m = 0; m < 4; ++m) _Pragma("unroll") for (int n = 0; n < 2; ++n) _Pragma("unroll") for (int k = 0; k < 2; ++k) \
        acc[ai][bj][m][n] = __builtin_amdgcn_mfma_f32_16x16x32_bf16(Bt[n][k], At[m][k], acc[ai][bj][m][n], 0, 0, 0); __builtin_amdgcn_s_setprio(0); } while (0)
#define PG8_WAIT_V(n) asm volatile("s_waitcnt vmcnt(" #n ")" ::: "memory")
#define PG8_WAIT_L(n) asm volatile("s_waitcnt lgkmcnt(" #n ")" ::: "memory")
#define PG8_BAR __builtin_amdgcn_s_barrier()
#define PG8_SCHED __builtin_amdgcn_sched_barrier(0)
    Unit cur, nxt; int ui = 0;
    if (!S.next(0, cur)) return;
    f32x4 acc[2][2][4][2];
#pragma unroll
    for (int a = 0; a < 2; ++a)
#pragma unroll
        for (int b = 0; b < 2; ++b)
#pragma unroll
            for (int m = 0; m < 4; ++m)
#pragma unroll
                for (int n = 0; n < 2; ++n) acc[a][b][m][n] = (f32x4){0.f, 0.f, 0.f, 0.f};
    bf16x8 At[4][2], B0[2][2], B1[2][2];
    const char* cA = (const char*)g.A + (size_t)cur.pm * tstep; const char* cB = (const char*)g.Bt + (size_t)cur.pn * tstep;
    S.a_ready(cur);
    PG8_STAGE(PG8_SB(0, 0), cB, voffB); PG8_STAGE(PG8_SA(0, 0), cA, voffA); PG8_STAGE(PG8_SB(0, 1), cB + hstep, voffB); PG8_STAGE(PG8_SA(0, 1), cA + hstep, voffA);
    if (wr == 1) PG8_BAR;
    PG8_WAIT_V(4); PG8_BAR;
    PG8_STAGE(PG8_SB(1, 0), cB + kstep, voffB); PG8_STAGE(PG8_SA(1, 0), cA + kstep, voffA); PG8_STAGE(PG8_SB(1, 1), cB + hstep + kstep, voffB);
    PG8_WAIT_V(6); PG8_BAR;
    PG8_STAMP();
    for (;;) {
        const bool has_next = S.next(ui + 1, nxt);
        const char* nA = has_next ? (const char*)g.A + (size_t)nxt.pm * tstep : cA; const char* nB = has_next ? (const char*)g.Bt + (size_t)nxt.pn * tstep : cB;
        for (int t = 0; t < nt; t += 2) {
            const bool last = (t == nt - 2);
            const char* a1 = cA + (size_t)(t + 1) * kstep;
            const char* a2 = last ? nA : cA + (size_t)(t + 2) * kstep; const char* b2 = last ? nB : cB + (size_t)(t + 2) * kstep;
            const char* a3 = a2 + kstep; const char* b3 = b2 + kstep;
            if (last && has_next) S.a_ready(nxt);
            PG8_LDB(B0, 0, 0); PG8_SCHED; PG8_LDA(At, 0, 0); PG8_STAGE(PG8_SA(1, 1), a1 + hstep, voffA);
            PG8_WAIT_L(8); PG8_BAR; PG8_WAIT_L(0); PG8_MMA(0, 0, At, B0); PG8_BAR; PG8_SCHED;
            PG8_LDB(B1, 0, 1); PG8_STAGE(PG8_SB(0, 0), b2, voffB);
            PG8_BAR; PG8_WAIT_L(0); PG8_MMA(0, 1, At, B1); PG8_BAR;
            PG8_LDA(At, 0, 1); PG8_STAGE(PG8_SA(0, 0), a2, voffA);
            PG8_BAR; PG8_WAIT_L(0); PG8_MMA(1, 0, At, B0); PG8_BAR; PG8_SCHED;
            PG8_STAGE(PG8_SB(0, 1), b2 + hstep, voffB);
            PG8_WAIT_V(6); PG8_BAR; PG8_MMA(1, 1, At, B1); PG8_BAR;
            PG8_LDB(B0, 1, 0); PG8_SCHED; PG8_LDA(At, 1, 0); PG8_STAGE(PG8_SA(0, 1), a2 + hstep, voffA);
            PG8_WAIT_L(8); PG8_BAR; PG8_WAIT_L(0); PG8_MMA(0, 0, At, B0); PG8_BAR; PG8_SCHED;
            PG8_LDB(B1, 1, 1); PG8_STAGE(PG8_SB(1, 0), b3, voffB);
            PG8_BAR; PG8_WAIT_L(0); PG8_MMA(0, 1, At, B1); PG8_BAR;
            PG8_LDA(At, 1, 1); PG8_STAGE(PG8_SA(1, 0), a3, voffA);
            PG8_BAR; PG8_WAIT_L(0); PG8_MMA(1, 0, At, B0); PG8_BAR; PG8_SCHED;
            PG8_STAGE(PG8_SB(1, 1), b3 + hstep, voffB);
            PG8_WAIT_V(6); PG8_BAR; PG8_MMA(1, 1, At, B1); PG8_BAR;
        }
        PG8_STAMP();
        if constexpr (!Epi::AFTER_DRAIN) { E(acc, cur, wr, wc, fr, fq); S.done(cur); }
        PG8_STAMP();
        if (!has_next) break;
#pragma unroll
        for (int a = 0; a < 2; ++a)
#pragma unroll
            for (int b = 0; b < 2; ++b)
#pragma unroll
                for (int m = 0; m < 4; ++m)
#pragma unroll
                    for (int n = 0; n < 2; ++n) acc[a][b][m][n] = (f32x4){0.f, 0.f, 0.f, 0.f};
        cur = nxt; cA = nA; cB = nB; ++ui;
    }
    PG8_WAIT_V(0);
    if (wr == 0) PG8_BAR;
    PG8_BAR;
    if constexpr (Epi::AFTER_DRAIN) { E.fused(acc, cur, wr, wc, fr, fq, lds, wid, lane); S.done(cur); }
    PG8_STAMP();
    if (STAMP && wid == 0) { stamps[lane] = lane < nts ? (((unsigned long long)(unsigned)ts_hi << 32) | (unsigned)ts_lo) : 0ull;
        if (lane == 62) stamps[62] = rt_entry; if (lane == 63) stamps[63] = (unsigned long long)wall_clock64(); }
#undef PG8_STAMP
#undef PG8_SA
#undef PG8_SB
#undef PG8_STAGE
#undef PG8_LDA
#undef PG8_LDB
#undef PG8_MMA
#undef PG8_WAIT_V
#undef PG8_WAIT_L
#undef PG8_BAR
#undef PG8_SCHED
}
}
using namespace pg8;
#define GSYNC() grid.sync()
typedef unsigned u32x2 __attribute__((ext_vector_type(2)));
typedef __bf16 bf2_t __attribute__((ext_vector_type(2)));

constexpr int NTOK = 32768, SEQL = 8192, DM = 1024;
constexpr size_t MIB = 1ull << 20;
constexpr size_t OFF_WIN = 0, OFF_WBR = 11 * MIB, OFF_WOUT = 13 * MIB, OFF_WC = 15 * MIB, OFF_LORA = 19 * MIB,
                 OFF_ADA = 19 * MIB + 512 * 1024, OFF_KMEAN = 19 * MIB + 640 * 1024, OFF_HBF = 20 * MIB, OFF_PR = 84 * MIB,
                 OFF_PM = 212 * MIB, OFF_PG = 308 * MIB, OFF_FREE = 436 * MIB;
constexpr size_t OFF_CTL = 19 * MIB + 896 * 1024;
constexpr int LDS_BYTES = 150528;

struct Params {
    const float *x, *c, *w_ada, *b_ada, *norm1_g, *w_in, *mu, *w0, *w2_decay, *a0, *a2_iclr, *g2_gate, *k_k, *k_a, *r_k, *lnx_w, *lnx_b,
                *q_norm_g, *k_norm_g, *w_branch, *w_out, *norm2_g, *w_peer_q, *sub_keys, *peer_u, *peer_v;
    float* out; unsigned char* ws;
};

__constant__ unsigned char cand_tab[64] = {
    0x00,0x01,0x02,0x03,0x04,0x05,0x06,0x07,0x08,0x09,0x0a,0x0b,0x0c,0x0d,0x0e,0x0f,
    0x10,0x11,0x12,0x13,0x14,0x15,0x16,0x17,
    0x20,0x21,0x22,0x23,0x24,
    0x30,0x31,0x32,0x33,
    0x40,0x41,0x42,
    0x50,0x51, 0x60,0x61, 0x70,0x71,
    0x80,0x90,0xa0,0xb0,0xc0,0xd0,0xe0,0xf0,
    0xff,0xff,0xff,0xff,0xff,0xff,0xff,0xff,0xff,0xff,0xff,0xff,0xff,0xff};

__device__ __forceinline__ float bflo(unsigned u) { return __uint_as_float(u << 16); }
__device__ __forceinline__ float bfhi(unsigned u) { return __uint_as_float(u & 0xffff0000u); }
__device__ __forceinline__ float sigmoidf_(float x) { return 1.0f / (1.0f + __expf(-x)); }
template <int CTRL, int RM = 0xF>
__device__ __forceinline__ float dppf(float x) { return __int_as_float(__builtin_amdgcn_update_dpp(__float_as_int(x), __float_as_int(x), CTRL, RM, 0xF, false)); }
template <int CTRL>
__device__ __forceinline__ float dppf0(float x) { return __int_as_float(__builtin_amdgcn_update_dpp(0, __float_as_int(x), CTRL, 0xF, 0xF, false)); }
__device__ __forceinline__ float row_sum16(float x) { x += dppf0<0xB1>(x); x += dppf0<0x4E>(x); x += dppf0<0x141>(x); x += dppf0<0x140>(x); return x; }
__device__ __forceinline__ float wave_max(float x) {
    x = fmaxf(x, dppf<0xB1>(x)); x = fmaxf(x, dppf<0x4E>(x)); x = fmaxf(x, dppf<0x141>(x)); x = fmaxf(x, dppf<0x140>(x));
    x = fmaxf(x, dppf<0x142, 0xA>(x)); x = fmaxf(x, dppf<0x143, 0xC>(x));
    return __int_as_float(__builtin_amdgcn_readlane(__float_as_int(x), 63));
}
__device__ __forceinline__ int sortkey(int f) { return f ^ ((f >> 31) & 0x7fffffff); }
template <int CTRL, int RM = 0xF>
__device__ __forceinline__ int dppi(int x) { return __builtin_amdgcn_update_dpp(x, x, CTRL, RM, 0xF, false); }
__device__ __forceinline__ int wave_max_i(int x) {
    x = max(x, __builtin_amdgcn_mov_dpp(x, 0xB1, 0xF, 0xF, true)); x = max(x, __builtin_amdgcn_mov_dpp(x, 0x4E, 0xF, 0xF, true));
    x = max(x, __builtin_amdgcn_mov_dpp(x, 0x141, 0xF, 0xF, true)); x = max(x, __builtin_amdgcn_mov_dpp(x, 0x140, 0xF, 0xF, true));
    x = max(x, dppi<0x142, 0xA>(x)); x = max(x, dppi<0x143, 0xC>(x));
    return __builtin_amdgcn_readlane(x, 63);
}
__device__ __forceinline__ void unpack8(const u32x4 v, float (&f)[8]) {
    f[0] = bflo(v.x); f[1] = bfhi(v.x); f[2] = bflo(v.y); f[3] = bfhi(v.y); f[4] = bflo(v.z); f[5] = bfhi(v.z); f[6] = bflo(v.w); f[7] = bfhi(v.w);
}
__device__ __forceinline__ u32x4 pack8(const float (&f)[8]) {
    u32x4 o; o.x = cvt_pk_bf16(f[0], f[1]); o.y = cvt_pk_bf16(f[2], f[3]); o.z = cvt_pk_bf16(f[4], f[5]); o.w = cvt_pk_bf16(f[6], f[7]); return o;
}

struct EpiProj {
    static constexpr bool PERM = true, AFTER_DRAIN = false;
    bf16_t *pr, *pm, *pg;
    __device__ __forceinline__ void operator()(const f32x4 (&acc)[2][2][4][2], const Unit& u, int wr, int wc, int fr, int fq) const {
        const int row0 = u.pm * BM + wr * 64 + fr; bf16_t* base; int ldc, colt; bool sig = false;
        if (u.pn < 8) { base = pr; ldc = 2048; colt = u.pn * 256; } else if (u.pn < 14) { base = pm; ldc = 1536; colt = (u.pn - 8) * 256; } else { base = pg; ldc = 2048; colt = (u.pn - 14) * 256; sig = true; }
        const int col0 = colt + wc * 32 + 8 * fq;
#pragma unroll
        for (int ai = 0; ai < 2; ++ai)
#pragma unroll
            for (int m = 0; m < 4; ++m) { bf16_t* rowp = base + (size_t)(row0 + ai * HALF + m * 16) * ldc + col0;
#pragma unroll
                for (int bj = 0; bj < 2; ++bj) { f32x4 v0 = acc[ai][bj][m][0], v1 = acc[ai][bj][m][1];
                    if (sig) {
#pragma unroll
                        for (int j = 0; j < 4; ++j) { v0[j] = sigmoidf_(v0[j]); v1[j] = sigmoidf_(v1[j]); } }
                    u32x4 w; w.x = cvt_pk_bf16(v0[0], v0[1]); w.y = cvt_pk_bf16(v0[2], v0[3]); w.z = cvt_pk_bf16(v1[0], v1[1]); w.w = cvt_pk_bf16(v1[2], v1[3]);
                    *(u32x4*)(rowp + bj * HALF) = w; } }
    }
};
template <int WHICH, int GOFF> struct EpiMerge {
    static constexpr bool PERM = true, AFTER_DRAIN = false;
    const bf16_t* gates; bf16_t* t0; bf16_t* mix;
    __device__ __forceinline__ void operator()(const f32x4 (&acc)[2][2][4][2], const Unit& u, int wr, int wc, int fr, int fq) const {
        const int row0 = u.pm * BM + wr * 64 + fr, col0 = u.pn * BM + wc * 32 + 8 * fq;
#pragma unroll
        for (int ai = 0; ai < 2; ++ai)
#pragma unroll
            for (int m = 0; m < 4; ++m) { const size_t row = (size_t)(row0 + ai * HALF + m * 16);
#pragma unroll
                for (int bj = 0; bj < 2; ++bj) { const int c = col0 + bj * HALF;
                    const u32x4 gv = *(const u32x4*)(gates + row * 2048 + GOFF + c); float g[8]; unpack8(gv, g);
                    const f32x4 v0 = acc[ai][bj][m][0], v1 = acc[ai][bj][m][1]; float r[8];
#pragma unroll
                    for (int j = 0; j < 4; ++j) { r[j] = g[j] * v0[j]; r[4 + j] = g[4 + j] * v1[j]; }
                    if (WHICH == 1) { const u32x4 tv = *(const u32x4*)(t0 + row * 1024 + c); float t[8]; unpack8(tv, t);
#pragma unroll
                        for (int j = 0; j < 8; ++j) r[j] += t[j];
                        *(u32x4*)(mix + row * 1024 + c) = pack8(r); }
                    else *(u32x4*)(t0 + row * 1024 + c) = pack8(r); } }
    }
};
struct EpiOut {
    static constexpr bool PERM = false, AFTER_DRAIN = false;
    const float* x; const float* ada; float* out;
    __device__ __forceinline__ void operator()(const f32x4 (&acc)[2][2][4][2], const Unit& u, int wr, int wc, int fr, int fq) const {
        const int row0 = u.pm * BM + wr * 64 + fr, col0 = u.pn * BM + wc * 32 + 4 * fq; const int b = (u.pm * BM) / SEQL;
        f32x4 gv[2][2];
#pragma unroll
        for (int bj = 0; bj < 2; ++bj)
#pragma unroll
            for (int n = 0; n < 2; ++n) gv[bj][n] = *(const f32x4*)(ada + b * 6144 + 2048 + col0 + bj * HALF + n * 16);
#pragma unroll
        for (int ai = 0; ai < 2; ++ai)
#pragma unroll
            for (int m = 0; m < 4; ++m) { const size_t off = (size_t)(row0 + ai * HALF + m * 16) * DM + col0;
#pragma unroll
                for (int bj = 0; bj < 2; ++bj)
#pragma unroll
                    for (int n = 0; n < 2; ++n) { const f32x4 xv = *(const f32x4*)(x + off + bj * HALF + n * 16);
                        *(f32x4*)(out + off + bj * HALF + n * 16) = xv + gv[bj][n] * acc[ai][bj][m][n]; } }
    }
};
struct EpiScore {
    static constexpr bool PERM = true, AFTER_DRAIN = false;
    bf16_t* O;
    __device__ __forceinline__ void operator()(const f32x4 (&acc)[2][2][4][2], const Unit& u, int wr, int wc, int fr, int fq) const {
        const int row0 = u.pm * BM + wr * 64 + fr, col0 = u.pn * BM + wc * 32 + 8 * fq;
#pragma unroll
        for (int ai = 0; ai < 2; ++ai)
#pragma unroll
            for (int m = 0; m < 4; ++m) { bf16_t* rowp = O + (size_t)(row0 + ai * HALF + m * 16) * 2048 + col0;
#pragma unroll
                for (int bj = 0; bj < 2; ++bj) { const f32x4 v0 = acc[ai][bj][m][0], v1 = acc[ai][bj][m][1];
                    u32x4 w; w.x = cvt_pk_bf16(v0[0], v0[1]); w.y = cvt_pk_bf16(v0[2], v0[3]); w.z = cvt_pk_bf16(v1[0], v1[1]); w.w = cvt_pk_bf16(v1[2], v1[3]);
                    *(u32x4*)(rowp + bj * HALF) = w; } }
    }
};

template <int MODE>
__device__ __forceinline__ void transpose_bf16(const float* __restrict__ W, int K, int Nsrc, bf16_t* __restrict__ Bt, int Nout, size_t gtid, size_t gstride) {
    const size_t total = (size_t)Nout * (K / 8);
    for (size_t it = gtid; it < total; it += gstride) {
        const int n = (int)(it % Nout), k8 = (int)(it / Nout);
        int src = n; if (MODE == 1) src = n < 1824 ? n : (n < 2048 ? -1 : n - 224);
        u32x4 o = {0u, 0u, 0u, 0u};
        if (src >= 0) { const float* p = W + (size_t)(k8 * 8) * Nsrc + src; float v[8];
#pragma unroll
            for (int j = 0; j < 8; ++j) v[j] = p[(size_t)j * Nsrc];
            o = pack8(v); }
        *(u32x4*)(Bt + (size_t)n * K + k8 * 8) = o;
    }
}

__device__ void phase0_ada(const Params& P, unsigned char* smem) {
    const int tid = threadIdx.x, wid = tid >> 6, lane = tid & 63;
    const size_t gtid = (size_t)blockIdx.x * 512 + tid, gstride = (size_t)gridDim.x * 512;
    unsigned char* ws = P.ws;
    (void)gtid; (void)gstride;
    float* red = (float*)smem; float* ada = (float*)(ws + OFF_ADA);
    for (int task = blockIdx.x; task < 96; task += gridDim.x) {
        const int col = task * 64 + lane; float a0 = 0.f, a1 = 0.f, a2 = 0.f, a3 = 0.f;
        for (int kk = 0; kk < 128; ++kk) { const int k = wid * 128 + kk; const float wv = P.w_ada[(size_t)k * 6144 + col];
            const float c0 = P.c[k], c1 = P.c[1024 + k], c2 = P.c[2048 + k], c3 = P.c[3072 + k];
            a0 += c0 * sigmoidf_(c0) * wv; a1 += c1 * sigmoidf_(c1) * wv; a2 += c2 * sigmoidf_(c2) * wv; a3 += c3 * sigmoidf_(c3) * wv; }
        red[(wid * 4 + 0) * 64 + lane] = a0; red[(wid * 4 + 1) * 64 + lane] = a1; red[(wid * 4 + 2) * 64 + lane] = a2; red[(wid * 4 + 3) * 64 + lane] = a3;
        __syncthreads();
        if (tid < 256) { const int b = tid >> 6, l = tid & 63; float s = P.b_ada[task * 64 + l];
            for (int w = 0; w < 8; ++w) s += red[(w * 4 + b) * 64 + l];
            ada[b * 6144 + task * 64 + l] = s; }
        __syncthreads();
    }
}

__device__ void phase0_weights(const Params& P) {
    const size_t gtid = (size_t)blockIdx.x * 512 + threadIdx.x, gstride = (size_t)gridDim.x * 512;
    unsigned char* ws = P.ws;
    transpose_bf16<1>(P.w_in, 1024, 5408, (bf16_t*)(ws + OFF_WIN), 5632, gtid, gstride);
    transpose_bf16<0>(P.w_branch + 512 * 1024, 512, 1024, (bf16_t*)(ws + OFF_WBR) + 1024 * 512, 1024, gtid, gstride);
    transpose_bf16<0>(P.w2_decay, 64, 512, (bf16_t*)(ws + OFF_LORA), 512, gtid, gstride);
    transpose_bf16<0>(P.a2_iclr, 64, 512, (bf16_t*)(ws + OFF_LORA) + 512 * 64, 512, gtid, gstride);
    transpose_bf16<0>(P.g2_gate, 160, 512, (bf16_t*)(ws + OFF_LORA) + 2 * 512 * 64, 512, gtid, gstride);
}
__device__ void phase0_weights_late(const Params& P, unsigned char* smem, int bid, int nb) {
    const int tid = threadIdx.x;
    const size_t gtid = (size_t)bid * 512 + tid, gstride = (size_t)nb * 512;
    unsigned char* ws = P.ws;
    transpose_bf16<0>(P.w_branch, 512, 1024, (bf16_t*)(ws + OFF_WBR), 1024, gtid, gstride);
    transpose_bf16<0>(P.w_out, 1024, 1024, (bf16_t*)(ws + OFF_WOUT), 1024, gtid, gstride);
    float* WqS = (float*)smem; float* KgT = (float*)(smem + 32768); bf16_t* WcT = (bf16_t*)(ws + OFF_WC);
    for (int task = bid; task < 256; task += nb) {
        const int g = task >> 4, kt = task & 15, h = g >> 1, half = g & 1;
#pragma unroll
        for (int i = 0; i < 4; ++i) { const int idx = tid + i * 512, r = idx >> 5, d4 = idx & 31;
            *(f32x4*)(WqS + r * 128 + d4 * 4) = *(const f32x4*)(P.w_peer_q + (size_t)(kt * 64 + r) * 2048 + h * 256 + half * 128 + d4 * 4); }
#pragma unroll
        for (int i = 0; i < 8; ++i) { const int idx = tid + i * 512, key = idx >> 5, d4 = idx & 31;
            const f32x4 v = *(const f32x4*)(P.sub_keys + ((size_t)((half * 8 + h) * 128 + key)) * 128 + d4 * 4);
            KgT[(d4 * 4 + 0) * 129 + key] = v[0]; KgT[(d4 * 4 + 1) * 129 + key] = v[1]; KgT[(d4 * 4 + 2) * 129 + key] = v[2]; KgT[(d4 * 4 + 3) * 129 + key] = v[3]; }
        __syncthreads();
        const int key = tid & 127, kq = tid >> 7; float acc[16];
#pragma unroll
        for (int i = 0; i < 16; ++i) acc[i] = 0.f;
        for (int d4 = 0; d4 < 32; ++d4) {
            const float k0 = KgT[(d4 * 4 + 0) * 129 + key], k1 = KgT[(d4 * 4 + 1) * 129 + key], k2 = KgT[(d4 * 4 + 2) * 129 + key], k3 = KgT[(d4 * 4 + 3) * 129 + key];
#pragma unroll
            for (int i = 0; i < 16; ++i) { const f32x4 w4 = *(const f32x4*)(WqS + (kq * 16 + i) * 128 + d4 * 4); acc[i] += w4[0] * k0 + w4[1] * k1 + w4[2] * k2 + w4[3] * k3; }
        }
        bf16_t* dst = WcT + (size_t)(g * 128 + key) * 1024 + kt * 64 + kq * 16;
        u32x4 o0, o1; o0.x = cvt_pk_bf16(acc[0], acc[1]); o0.y = cvt_pk_bf16(acc[2], acc[3]); o0.z = cvt_pk_bf16(acc[4], acc[5]); o0.w = cvt_pk_bf16(acc[6], acc[7]);
        o1.x = cvt_pk_bf16(acc[8], acc[9]); o1.y = cvt_pk_bf16(acc[10], acc[11]); o1.z = cvt_pk_bf16(acc[12], acc[13]); o1.w = cvt_pk_bf16(acc[14], acc[15]);
        *(u32x4*)dst = o0; *(u32x4*)(dst + 8) = o1;
        __syncthreads();
    }
}

__device__ void phase_norm(const float* __restrict__ X, const float* __restrict__ gain, const float* __restrict__ ada, int shift_off, int scale_off, bf16_t* __restrict__ H) {
    const int lane = threadIdx.x & 63, gw = blockIdx.x * 8 + (threadIdx.x >> 6), nw = gridDim.x * 8;
    for (int row = gw; row < NTOK; row += nw) {
        const int b = row / SEQL; const float* xr = X + (size_t)row * DM; f32x4 v[4]; float ss = 0.f;
#pragma unroll
        for (int i = 0; i < 4; ++i) { v[i] = *(const f32x4*)(xr + (i >> 1) * 512 + lane * 8 + (i & 1) * 4); ss += v[i][0] * v[i][0] + v[i][1] * v[i][1] + v[i][2] * v[i][2] + v[i][3] * v[i][3]; }
        ss += __shfl_xor(ss, 1); ss += __shfl_xor(ss, 2); ss += __shfl_xor(ss, 4); ss += __shfl_xor(ss, 8); ss += __shfl_xor(ss, 16); ss += __shfl_xor(ss, 32);
        const float rinv = rsqrtf(ss * (1.0f / 1024.0f) + 1e-6f);
#pragma unroll
        for (int ih = 0; ih < 2; ++ih) { u32x4 o;
#pragma unroll
            for (int q = 0; q < 2; ++q) { const int c = ih * 512 + lane * 8 + q * 4; const f32x4 g = *(const f32x4*)(gain + c), sh = *(const f32x4*)(ada + b * 6144 + shift_off + c), sc = *(const f32x4*)(ada + b * 6144 + scale_off + c);
                const f32x4 h = v[ih * 2 + q] * rinv * g * (sc + 1.0f) + sh;
                if (q == 0) { o.x = cvt_pk_bf16(h[0], h[1]); o.y = cvt_pk_bf16(h[2], h[3]); } else { o.z = cvt_pk_bf16(h[0], h[1]); o.w = cvt_pk_bf16(h[2], h[3]); } }
            *(u32x4*)(H + (size_t)row * DM + ih * 512 + lane * 8) = o; }
    }
}

struct ScanBufs { bf16_t *sr, *sw, *sk, *sv, *skk, *sb, *g1, *g2; };
__device__ __forceinline__ float lerp_bf(unsigned short p, unsigned short pp, float mu) { const float a = __uint_as_float((unsigned)p << 16), b = __uint_as_float((unsigned)pp << 16); return a + (b - a) * mu; }
__device__ __forceinline__ unsigned prev_dw(unsigned x, unsigned first) { return (unsigned)__builtin_amdgcn_update_dpp((int)first, (int)x, 0x111, 0xF, 0xF, false); }
__device__ __forceinline__ u32x2 prev_v2(const u32x2 x, const u32x2 first) { u32x2 r; r.x = prev_dw(x.x, first.x); r.y = prev_dw(x.y, first.y); return r; }
__device__ void phase_rwkv_prep(const Params& P, const ScanBufs& S, unsigned char* smem) {
    const int lane = threadIdx.x & 63, gw = blockIdx.x * 8 + (threadIdx.x >> 6), nw = gridDim.x * 8, fr = lane & 15, fq = lane >> 4;
    const bf16_t* projR = (const bf16_t*)(P.ws + OFF_PR); const bf16_t* w2t = (const bf16_t*)(P.ws + OFF_LORA); const bf16_t* a2t = w2t + 512 * 64; const bf16_t* g2t = w2t + 2 * 512 * 64;
#pragma unroll 1
    for (int tt = gw; tt < NTOK / 16; tt += nw) {
        const int t = tt * 16 + fr, b = t / SEQL, s = t - b * SEQL; const bool hp0 = (fr == 0) && (s != 0);
        const bf16_t* prow = projR + (size_t)t * 2048; const bf16_t* pprev = prow - 2048;
        unsigned char* tokS = smem + (threadIdx.x >> 6) * 9216 + lane * 16;
#pragma unroll
        for (int kb = 0; kb < 9; ++kb) { const int c = 1536 + kb * 32 + fq * 8; const u32x4 pv = *(const u32x4*)(prow + c); u32x4 q0 = {0u, 0u, 0u, 0u}; if (hp0) q0 = *(const u32x4*)(pprev + c);
            u32x4 qv; qv.x = prev_dw(pv.x, q0.x); qv.y = prev_dw(pv.y, q0.y); qv.z = prev_dw(pv.z, q0.z); qv.w = prev_dw(pv.w, q0.w);
            float a[8], q[8]; unpack8(pv, a); unpack8(qv, q); const f32x4 m0 = *(const f32x4*)(P.mu + c), m1 = *(const f32x4*)(P.mu + c + 4);
#pragma unroll
            for (int j = 0; j < 8; ++j) { const float mu = j < 4 ? m0[j] : m1[j - 4]; float xm = a[j] + (q[j] - a[j]) * mu;
                if (kb < 2) xm = 1.0f - 2.0f / (__expf(2.0f * xm) + 1.0f); else if (kb >= 4) xm = sigmoidf_(xm);
                a[j] = xm; }
            const u32x4 pk = pack8(a); *(u32x4*)(tokS + kb * 1024) = pk; }
        u32x2 cr[4], ck[4], cv[4];
#pragma unroll
        for (int n = 0; n < 4; ++n) { const int c0 = n * 16 + fq * 4; cr[n] = *(const u32x2*)(prow + c0); ck[n] = *(const u32x2*)(prow + 512 + c0); cv[n] = *(const u32x2*)(prow + 1024 + c0); }
#pragma unroll 1
        for (int h = 0; h < 8; ++h) {
            u32x2 nr[4], nk[4], nv[4];
#pragma unroll
            for (int n = 0; n < 4; ++n) { const int c0 = (h < 7 ? h + 1 : 7) * 64 + n * 16 + fq * 4; nr[n] = *(const u32x2*)(prow + c0); nk[n] = *(const u32x2*)(prow + 512 + c0); nv[n] = *(const u32x2*)(prow + 1024 + c0); }
            f32x4 accw[4], acca[4], accg[4];
#pragma unroll
            for (int n = 0; n < 4; ++n) { const int oc = h * 64 + n * 16 + fr; accw[n] = (f32x4){0.f, 0.f, 0.f, 0.f}; acca[n] = accw[n]; accg[n] = accw[n];
#pragma unroll
                for (int kb = 0; kb < 2; ++kb) { const bf16x8 wf = *(const bf16x8*)(w2t + oc * 64 + kb * 32 + fq * 8); accw[n] = __builtin_amdgcn_mfma_f32_16x16x32_bf16(wf, *(const bf16x8*)(tokS + kb * 1024), accw[n], 0, 0, 0); }
#pragma unroll
                for (int kb = 0; kb < 2; ++kb) { const bf16x8 wf = *(const bf16x8*)(a2t + oc * 64 + kb * 32 + fq * 8); acca[n] = __builtin_amdgcn_mfma_f32_16x16x32_bf16(wf, *(const bf16x8*)(tokS + (2 + kb) * 1024), acca[n], 0, 0, 0); }
#pragma unroll
                for (int kb = 0; kb < 5; ++kb) { const bf16x8 wf = *(const bf16x8*)(g2t + oc * 160 + kb * 32 + fq * 8); accg[n] = __builtin_amdgcn_mfma_f32_16x16x32_bf16(wf, *(const bf16x8*)(tokS + (4 + kb) * 1024), accg[n], 0, 0, 0); }
                 }
            const size_t obase = ((size_t)(b * 8 + h) * SEQL + s) * 64;
            float ss = 0.f, bon = 0.f;
#pragma unroll
            for (int n = 0; n < 4; ++n) { const int c0 = h * 64 + n * 16 + fq * 4;
                const u32x2 k2 = ck[n]; u32x2 kp0 = {0u, 0u}; if (hp0) kp0 = *(const u32x2*)(pprev + 512 + c0); const u32x2 kp = prev_v2(k2, kp0);
                const f32x4 muk = *(const f32x4*)(P.mu + 512 + c0), kkp = *(const f32x4*)(P.k_k + c0);
                const float k0 = bflo(k2.x), k1 = bfhi(k2.x), k2_ = bflo(k2.y), k3 = bfhi(k2.y), q0 = bflo(kp.x), q1 = bfhi(kp.x), q2 = bflo(kp.y), q3 = bfhi(kp.y);
                const float e0 = (k0 + (q0 - k0) * muk[0]) * kkp[0], e1 = (k1 + (q1 - k1) * muk[1]) * kkp[1], e2 = (k2_ + (q2 - k2_) * muk[2]) * kkp[2], e3 = (k3 + (q3 - k3) * muk[3]) * kkp[3];
                ss += e0 * e0 + e1 * e1 + e2 * e2 + e3 * e3; }
            ss += __shfl_xor(ss, 16); ss += __shfl_xor(ss, 32);
            const float inv = 1.0f / fmaxf(sqrtf(ss), 1e-12f);

#pragma unroll
            for (int n = 0; n < 4; ++n) { const int c0 = h * 64 + n * 16 + fq * 4;
                const u32x2 r2 = cr[n], k2 = ck[n];
                u32x2 rp0 = {0u, 0u}, kp0 = {0u, 0u}; if (hp0) { rp0 = *(const u32x2*)(pprev + c0); kp0 = *(const u32x2*)(pprev + 512 + c0); } const u32x2 rp = prev_v2(r2, rp0), kp = prev_v2(k2, kp0);
                const f32x4 mur = *(const f32x4*)(P.mu + c0), muk = *(const f32x4*)(P.mu + 512 + c0);
                const f32x4 w0v = *(const f32x4*)(P.w0 + c0), a0v = *(const f32x4*)(P.a0 + c0), kkp = *(const f32x4*)(P.k_k + c0), kap = *(const f32x4*)(P.k_a + c0), rkp = *(const f32x4*)(P.r_k + c0), lw = *(const f32x4*)(P.lnx_w + c0);
                float rr[4], kn[4], om[4], kk[4], bb[4], g1[4];
#pragma unroll
                for (int j = 0; j < 4; ++j) {
                    const unsigned rw = j < 2 ? r2.x : r2.y, rpw = j < 2 ? rp.x : rp.y, kw = j < 2 ? k2.x : k2.y, kpw = j < 2 ? kp.x : kp.y;
                    const float r_ = (j & 1) ? bfhi(rw) : bflo(rw), rp_ = (j & 1) ? bfhi(rpw) : bflo(rpw), k_ = (j & 1) ? bfhi(kw) : bflo(kw), kp_ = (j & 1) ? bfhi(kpw) : bflo(kpw);
                    const float r = r_ + (rp_ - r_) * mur[j], k = k_ + (kp_ - k_) * muk[j];
                    const float wl = w0v[j] + accw[n][j]; const float z = -wl; const float sp = fmaxf(z, 0.f) + __logf(1.0f + __expf(-fabsf(z)));
                    const float e = __expf(-sp - 0.5f); om[j] = 1.0f - __expf(-e);
                    const float a = sigmoidf_(a0v[j] + acca[n][j]);
                    kk[j] = k * kkp[j] * inv; bb[j] = kk[j] * a;
                    kn[j] = k * (1.0f + (a - 1.0f) * kap[j]); rr[j] = r; bon += r * kn[j] * rkp[j]; g1[j] = lw[j] * accg[n][j];
                }
                u32x2 o; o.x = cvt_pk_bf16(rr[0], rr[1]); o.y = cvt_pk_bf16(rr[2], rr[3]); *(u32x2*)(S.sr + obase + n * 16 + fq * 4) = o;
                o.x = cvt_pk_bf16(om[0], om[1]); o.y = cvt_pk_bf16(om[2], om[3]); *(u32x2*)(S.sw + obase + n * 16 + fq * 4) = o;
                o.x = cvt_pk_bf16(kn[0], kn[1]); o.y = cvt_pk_bf16(kn[2], kn[3]); *(u32x2*)(S.sk + obase + n * 16 + fq * 4) = o;
                o.x = cvt_pk_bf16(kk[0], kk[1]); o.y = cvt_pk_bf16(kk[2], kk[3]); *(u32x2*)(S.skk + obase + n * 16 + fq * 4) = o;
                o.x = cvt_pk_bf16(bb[0], bb[1]); o.y = cvt_pk_bf16(bb[2], bb[3]); *(u32x2*)(S.sb + obase + n * 16 + fq * 4) = o;
                o.x = cvt_pk_bf16(g1[0], g1[1]); o.y = cvt_pk_bf16(g1[2], g1[3]); *(u32x2*)(S.g1 + obase + n * 16 + fq * 4) = o;

            }
            bon += __shfl_xor(bon, 16); bon += __shfl_xor(bon, 32);
#pragma unroll
            for (int n = 0; n < 4; ++n) { const int c0 = h * 64 + n * 16 + fq * 4;
                const u32x2 v2 = cv[n]; u32x2 vp0 = {0u, 0u}; if (hp0) vp0 = *(const u32x2*)(pprev + 1024 + c0); const u32x2 vp = prev_v2(v2, vp0);
                const f32x4 muv = *(const f32x4*)(P.mu + 1024 + c0), lb = *(const f32x4*)(P.lnx_b + c0);
                const float v0 = bflo(v2.x), v1 = bfhi(v2.x), v2_ = bflo(v2.y), v3 = bfhi(v2.y), q0 = bflo(vp.x), q1 = bfhi(vp.x), q2 = bflo(vp.y), q3 = bfhi(vp.y);
                float vv[4]; vv[0] = v0 + (q0 - v0) * muv[0]; vv[1] = v1 + (q1 - v1) * muv[1]; vv[2] = v2_ + (q2 - v2_) * muv[2]; vv[3] = v3 + (q3 - v3) * muv[3];
                float g2[4];
#pragma unroll
                for (int j = 0; j < 4; ++j) g2[j] = (lb[j] + bon * vv[j]) * accg[n][j];
                u32x2 o; o.x = cvt_pk_bf16(vv[0], vv[1]); o.y = cvt_pk_bf16(vv[2], vv[3]); *(u32x2*)(S.sv + obase + n * 16 + fq * 4) = o;
                o.x = cvt_pk_bf16(g2[0], g2[1]); o.y = cvt_pk_bf16(g2[2], g2[3]); *(u32x2*)(S.g2 + obase + n * 16 + fq * 4) = o;
            }

#pragma unroll
            for (int n = 0; n < 4; ++n) { cr[n] = nr[n]; ck[n] = nk[n]; cv[n] = nv[n]; }
        }
    }
}

__device__ void phase_moba_prep(const Params& P, unsigned char* smem) {
    const int tid = threadIdx.x; bf16_t* projM = (bf16_t*)(P.ws + OFF_PM); float* kmean = (float*)(P.ws + OFF_KMEAN);
    float* kred = (float*)smem;
    float* part = (float*)(smem + 66560);
    bf16_t* Vs = (bf16_t*)(smem + 66560 + 2048);
    for (int task = blockIdx.x; task < 1024; task += gridDim.x) {
        const int h = task & 7, blk = (task >> 3) & 31, b = task >> 8; const size_t tok0 = (size_t)b * SEQL + blk * 256;
#pragma unroll 2
        for (int ps = 0; ps < 8; ++ps) { const int rowid = ps * 64 + (tid >> 3), part_ = rowid >> 8, token = rowid & 255, seg = tid & 7;
            bf16_t* ptr = projM + (tok0 + token) * 1536 + part_ * 512 + h * 64 + seg * 8; const float* gn = (part_ ? P.k_norm_g : P.q_norm_g) + seg * 8;
            const u32x4 v = *(const u32x4*)ptr; float f[8]; unpack8(v, f); float ss = 0.f;
#pragma unroll
            for (int j = 0; j < 8; ++j) ss += f[j] * f[j];
            ss += dppf0<0xB1>(ss); ss += dppf0<0x4E>(ss); ss += dppf0<0x141>(ss);
            const float rinv = rsqrtf(ss * (1.0f / 64.0f) + 1e-6f) * (part_ ? 1.0f : 0.125f * 1.4426950408889634f);
            const f32x4 g0 = *(const f32x4*)gn, g1 = *(const f32x4*)(gn + 4);
#pragma unroll
            for (int j = 0; j < 8; ++j) { f[j] = f[j] * rinv * (j < 4 ? g0[j] : g1[j - 4]); if (part_) kred[token * 65 + seg * 8 + j] = f[j]; }
            *(u32x4*)ptr = pack8(f); }
#pragma unroll
        for (int i = 0; i < 4; ++i) { const int c = tid + i * 512, key = c >> 3, d8 = c & 7; const u32x4 v = *(const u32x4*)(projM + (tok0 + key) * 1536 + 1024 + h * 64 + d8 * 8);
            unsigned short* d = (unsigned short*)(Vs + key * 65 + d8 * 8);
            d[0] = (unsigned short)(v.x & 0xffff); d[1] = (unsigned short)(v.x >> 16); d[2] = (unsigned short)(v.y & 0xffff); d[3] = (unsigned short)(v.y >> 16);
            d[4] = (unsigned short)(v.z & 0xffff); d[5] = (unsigned short)(v.z >> 16); d[6] = (unsigned short)(v.w & 0xffff); d[7] = (unsigned short)(v.w >> 16); }
        __syncthreads();
        { const int d = tid & 63, seg = tid >> 6; float s = 0.f; for (int i = 0; i < 32; ++i) s += kred[(seg * 32 + i) * 65 + d]; part[seg * 64 + d] = s; }
#pragma unroll
        for (int i = 0; i < 4; ++i) { const int c = tid + i * 512, d = c >> 5, key8 = c & 31; unsigned short e[8];
#pragma unroll
            for (int j = 0; j < 8; ++j) e[j] = Vs[(key8 * 8 + j) * 65 + d];
            u32x4 o; o.x = e[0] | ((unsigned)e[1] << 16); o.y = e[2] | ((unsigned)e[3] << 16); o.z = e[4] | ((unsigned)e[5] << 16); o.w = e[6] | ((unsigned)e[7] << 16);
            *(u32x4*)(projM + (tok0 + d * 4 + (key8 >> 3)) * 1536 + 1024 + h * 64 + (key8 & 7) * 8) = o; }
        __syncthreads();
        if (tid < 64) { float s = 0.f; for (int w = 0; w < 8; ++w) s += part[w * 64 + tid]; kmean[((size_t)((b * 8 + h) * 32 + blk)) * 64 + tid] = s * (1.0f / 256.0f); }
        __syncthreads();
    }
}

__device__ void phase_scan(const Params& P, const ScanBufs& S, float* __restrict__ Oraw, unsigned char* smem, int sb, int nsb, unsigned* prog) {
    const int tid = threadIdx.x, wid = tid >> 6, lane = tid & 63, g = lane >> 4, li = lane & 15;
    constexpr int BUFB = 5 * 8192 + 2048;
    for (int task = sb; task < 128; task += nsb) {
        const int seq = task >> 2, rowbase = (task & 3) * 16; const size_t sbase = (size_t)seq * SEQL * 64;
        const bf16_t* arr[5] = {S.skk, S.sw, S.sk, S.sb, S.sr};
        u32x4 ldA[5], ldB[5]; u32x4 ldvA = {0u, 0u, 0u, 0u}, ldvB = ldvA; const int stid = tid - 256;
        auto gload = [&](int c, u32x4 (&ld)[5], u32x4& ldv) {
            if (stid >= 0) {
#pragma unroll
                for (int a = 0; a < 5; ++a) ld[a] = *(const u32x4*)(arr[a] + sbase + (size_t)c * 2048 + stid * 8);
                if (stid < 64) ldv = *(const u32x4*)(S.sv + sbase + (size_t)(c * 32 + (stid >> 1)) * 64 + rowbase + (stid & 1) * 8); }
        };
        auto lstore = [&](int bufi, const u32x4 (&ld)[5], const u32x4& ldv) { unsigned char* bb = smem + bufi * BUFB;
            if (stid >= 0) {
#pragma unroll
                for (int a = 0; a < 5; ++a) { float f[8]; unpack8(ld[a], f);
                    if (a == 1) {
#pragma unroll
                        for (int j = 0; j < 8; ++j) f[j] = 1.0f - f[j]; }
                    *(f32x4*)(bb + a * 8192 + stid * 32) = (f32x4){f[0], f[1], f[2], f[3]}; *(f32x4*)(bb + a * 8192 + stid * 32 + 16) = (f32x4){f[4], f[5], f[6], f[7]}; }
                if (stid < 64) { float f[8]; unpack8(ldv, f); *(f32x4*)(bb + 5 * 8192 + stid * 32) = (f32x4){f[0], f[1], f[2], f[3]}; *(f32x4*)(bb + 5 * 8192 + stid * 32 + 16) = (f32x4){f[4], f[5], f[6], f[7]}; } }
        };
        f32x2 sA = {0.f, 0.f}, sB = {0.f, 0.f};
        const int row = rowbase + wid * 4 + g;
#define SC_LO(v) __builtin_shufflevector(v, v, 0, 1)
#define SC_HI(v) __builtin_shufflevector(v, v, 2, 3)
        auto compute = [&](int c) {
            if (wid < 4) {
                const unsigned char* bb = smem + (c & 1) * BUFB;
                float p;
                { const f32x4 kk = *(const f32x4*)(bb + li * 16); const f32x2 t = sA * SC_LO(kk) + sB * SC_HI(kk); p = row_sum16(t.x + t.y); }
                for (int hf = 0; hf < 2; ++hf) {
                    float qp[16];
#pragma unroll
                    for (int s16 = 0; s16 < 16; ++s16) { const int st = hf * 16 + s16;
                        const f32x4 w = *(const f32x4*)(bb + 1 * 8192 + st * 256 + li * 16), k = *(const f32x4*)(bb + 2 * 8192 + st * 256 + li * 16),
                                    bv = *(const f32x4*)(bb + 3 * 8192 + st * 256 + li * 16), r = *(const f32x4*)(bb + 4 * 8192 + st * 256 + li * 16),
                                    kn = *(const f32x4*)(bb + 0 * 8192 + (st + 1) * 256 + li * 16);
                        const float vv = *(const float*)(bb + 5 * 8192 + st * 64 + (wid * 4 + g) * 4);
                        const f32x2 pv = {p, p}, vv2 = {vv, vv};
                        sA = sA * SC_LO(w) + (SC_LO(k) * vv2 - SC_LO(bv) * pv); sB = sB * SC_HI(w) + (SC_HI(k) * vv2 - SC_HI(bv) * pv);
                        const f32x2 qq = sA * SC_LO(r) + sB * SC_HI(r), pp = sA * SC_LO(kn) + sB * SC_HI(kn);
                        qp[s16] = qq.x + qq.y; float pn = pp.x + pp.y;
                        pn += dppf0<0xB1>(pn); pn += dppf0<0x4E>(pn); pn += dppf0<0x141>(pn); pn += dppf0<0x140>(pn);
                        p = pn;
                        if ((s16 & 3) == 3) asm volatile("" ::: "memory");
                    }
                    float q8[8], q4[4], q2[2], qo;
                    { const bool hi = (li & 8) != 0;
#pragma unroll
                      for (int j = 0; j < 8; ++j) { const float send = hi ? qp[j] : qp[j + 8], keep = hi ? qp[j + 8] : qp[j]; q8[j] = keep + dppf0<0x140>(send); } }
                    { const bool hi = (li & 4) != 0;
#pragma unroll
                      for (int j = 0; j < 4; ++j) { const float send = hi ? q8[j] : q8[j + 4], keep = hi ? q8[j + 4] : q8[j]; q4[j] = keep + dppf0<0x141>(send); } }
                    { const bool hi = (li & 2) != 0;
#pragma unroll
                      for (int j = 0; j < 2; ++j) { const float send = hi ? q4[j] : q4[j + 2], keep = hi ? q4[j + 2] : q4[j]; q2[j] = keep + dppf0<0x1B>(send); } }
                    { const bool hi = (li & 1) != 0; const float send = hi ? q2[0] : q2[1], keep = hi ? q2[1] : q2[0]; qo = keep + dppf0<0xB1>(send); }
                    Oraw[((size_t)seq * 64 + row) * SEQL + c * 32 + hf * 16 + li] = qo;
                }
            }
        };
        gload(0, ldA, ldvA); lstore(0, ldA, ldvA); gload(1, ldB, ldvB); __syncthreads();
        for (int c = 0; c < 256; c += 2) {
            if (c + 2 < 256) gload(c + 2, ldA, ldvA);
            compute(c);
            lstore(1, ldB, ldvB);
            __syncthreads();
            if (c + 3 < 256) gload(c + 3, ldB, ldvB);
            compute(c + 1);
            if (c + 2 < 256) lstore(0, ldA, ldvA);
            __syncthreads();
            if (((c + 1) & 31) == 31 && tid == 0) { __builtin_amdgcn_fence(__ATOMIC_RELEASE, "agent"); __hip_atomic_fetch_add(prog + task * 16, 1u, __ATOMIC_RELAXED, __HIP_MEMORY_SCOPE_AGENT); }
        }
    }
}

__device__ void phase_moba(const Params& P, bf16_t* __restrict__ yb, unsigned char* smem, unsigned* queue, unsigned* udone) {
    const int tid = threadIdx.x, wid = tid >> 6, lane = tid & 63, g = lane >> 4, m = lane & 15;
    const bf16_t* projM = (const bf16_t*)(P.ws + OFF_PM); const float* kmean = (const float*)(P.ws + OFF_KMEAN);
    unsigned char* Ks = smem; unsigned char* Vts = smem + 36864; float* acc = (float*)(smem + 70656); float* kmS = (float*)(smem + 140288);
    int* cnt = (int*)(smem + 148480); int* offs = cnt + 32; unsigned short* list = (unsigned short*)(smem + 148800);
    int* qslot = (int*)(smem + 150336);
    int qx = (int)(blockIdx.x & 7), tries = 0;
    bool didone = false;
    for (;;) {
        __syncthreads();
        if (tid == 0) { if (didone) { __builtin_amdgcn_fence(__ATOMIC_RELEASE, "agent"); __hip_atomic_fetch_add(udone, 1u, __ATOMIC_RELAXED, __HIP_MEMORY_SCOPE_AGENT); }
            int n = -1, x = qx, tr = tries;
            while (tr < 8) { n = (int)atomicAdd(queue + x * 16, 1u); if (n < 128) break; n = -1; x = (x + 1) & 7; ++tr; }
            qslot[0] = n; qslot[1] = x; qslot[2] = tr; }
        __syncthreads();
        const int n = qslot[0]; qx = qslot[1]; tries = qslot[2]; if (n < 0) break;
        didone = true;
        const int bh = qx + 8 * (n >> 5), i = 31 - (n & 31);
        const int b = bh >> 3, h = bh & 7; const size_t tokb = (size_t)b * SEQL, tok0 = tokb + (size_t)i * 256;
        for (int e = tid; e < 256 * 68; e += 512) acc[e] = 0.f;
        for (int e = tid; e < i * 64; e += 512) kmS[e] = kmean[(size_t)(bh * 32) * 64 + e];
        if (tid < 32) cnt[tid] = 0;
        __syncthreads();
        int selj[3] = {-1, -1, -1}, slot[3] = {0, 0, 0}; const int nsel = i < 3 ? i : 3;
        if (tid < 256 && i > 0) {
            float q[64]; const bf16_t* qp = projM + (tok0 + tid) * 1536 + h * 64;
#pragma unroll
            for (int t8 = 0; t8 < 8; ++t8) { const u32x4 v = *(const u32x4*)(qp + t8 * 8); float f[8]; unpack8(v, f);
#pragma unroll
                for (int j = 0; j < 8; ++j) q[t8 * 8 + j] = f[j]; }
            float b0 = -3e38f, b1 = -3e38f, b2 = -3e38f; int j0 = -1, j1 = -1, j2 = -1;
            for (int j = 0; j < i; ++j) { float d = 0.f;
#pragma unroll
                for (int t4 = 0; t4 < 16; ++t4) { const f32x4 kv = *(const f32x4*)(kmS + j * 64 + t4 * 4); d += q[t4 * 4] * kv[0] + q[t4 * 4 + 1] * kv[1] + q[t4 * 4 + 2] * kv[2] + q[t4 * 4 + 3] * kv[3]; }
                if (d > b0) { b2 = b1; j2 = j1; b1 = b0; j1 = j0; b0 = d; j0 = j; } else if (d > b1) { b2 = b1; j2 = j1; b1 = d; j1 = j; } else if (d > b2) { b2 = d; j2 = j; } }
            selj[0] = j0; selj[1] = j1; selj[2] = j2;
#pragma unroll
            for (int s = 0; s < 3; ++s) if (s < nsel) slot[s] = atomicAdd(&cnt[selj[s]], 1);
        }
        __syncthreads();
        if (tid == 0) { int o = 0; for (int j = 0; j < 32; ++j) { offs[j] = o; o += cnt[j]; } offs[32] = o; }
        __syncthreads();
        if (tid < 256 && i > 0) {
#pragma unroll
            for (int s = 0; s < 3; ++s) if (s < nsel) list[offs[selj[s]] + slot[s]] = (unsigned short)tid;
        }
        __syncthreads();
        u32x4 kreg[4], vreg[4];
        auto tload = [&](int jt) { const size_t tokj = tokb + (size_t)jt * 256;
#pragma unroll
            for (int t4 = 0; t4 < 4; ++t4) { const int c = tid + t4 * 512;
                { const int key = c >> 3, d8 = c & 7; kreg[t4] = *(const u32x4*)(projM + (tokj + key) * 1536 + 512 + h * 64 + d8 * 8); }
                { const int d = c >> 5, key8 = c & 31; vreg[t4] = *(const u32x4*)(projM + (tokj + d * 4 + (key8 >> 3)) * 1536 + 1024 + h * 64 + (key8 & 7) * 8); } } };
        auto nexttile = [&](int from) { int jt = from; while (jt < i && cnt[jt] == 0) ++jt; return jt; };
        int jn = nexttile(0);
        tload(jn);
        while (jn <= i) {
            const int j = jn; const bool own = (j == i); const int nq = own ? 256 : cnt[j];
            const int ng = (nq + 15) >> 4, lbase = own ? 0 : offs[j];
            int qpos = wid * 16 + m; bool valid = qpos < nq; int qi = own ? qpos : (int)list[lbase + (valid ? qpos : 0)];
            bf16x8 qf0, qf1;
            { const bf16_t* qp = projM + (tok0 + qi) * 1536 + h * 64 + g * 8; qf0 = *(const bf16x8*)qp; qf1 = *(const bf16x8*)(qp + 32); }
            __syncthreads();
#pragma unroll
            for (int t4 = 0; t4 < 4; ++t4) { const int c = tid + t4 * 512;
                { const int key = c >> 3, d8 = c & 7; *(u32x4*)(Ks + key * 144 + d8 * 16) = kreg[t4]; }
                { const int d = c >> 5, key8 = c & 31; *(u32x4*)(Vts + d * 528 + key8 * 16) = vreg[t4]; } }
            __syncthreads();
            jn = own ? i + 1 : nexttile(j + 1);
            if (jn <= i) tload(jn);
            for (int grp = wid; grp < ng; grp += 8) {
                if (grp != wid) { qpos = grp * 16 + m; valid = qpos < nq; qi = own ? qpos : (int)list[lbase + (valid ? qpos : 0)];
                    const bf16_t* qp = projM + (tok0 + qi) * 1536 + h * 64 + g * 8; qf0 = *(const bf16x8*)qp; qf1 = *(const bf16x8*)(qp + 32); }
                const int nslab = own ? (grp >> 1) + 1 : 8;
                f32x4 o[4]; float dsum = 0.f; f32x4 osum = {0.f, 0.f, 0.f, 0.f}; const bf16x8 vones = {16256, 16256, 16256, 16256, 16256, 16256, 16256, 16256};
#pragma unroll
                for (int dt = 0; dt < 4; ++dt) o[dt] = (f32x4){0.f, 0.f, 0.f, 0.f};
                const unsigned char* kbase = Ks + (8 * (m >> 2) + (m & 3)) * 144 + g * 16; const unsigned char* vbase = Vts + m * 528 + g * 16;
                bf16x8 kf0 = *(const bf16x8*)(kbase), kf1 = *(const bf16x8*)(kbase + 64), kf2 = *(const bf16x8*)(kbase + 4 * 144), kf3 = *(const bf16x8*)(kbase + 4 * 144 + 64);
                for (int sl = 0; sl < nslab; ++sl) {
                    const bf16x8 vf0 = *(const bf16x8*)(vbase + sl * 64), vf1 = *(const bf16x8*)(vbase + 16 * 528 + sl * 64), vf2 = *(const bf16x8*)(vbase + 32 * 528 + sl * 64), vf3 = *(const bf16x8*)(vbase + 48 * 528 + sl * 64);
                    __builtin_amdgcn_sched_barrier(0);
                    f32x4 s0 = (f32x4){0.f, 0.f, 0.f, 0.f}, s1 = s0;
                    s0 = __builtin_amdgcn_mfma_f32_16x16x32_bf16(kf0, qf0, s0, 0, 0, 0);
                    s0 = __builtin_amdgcn_mfma_f32_16x16x32_bf16(kf1, qf1, s0, 0, 0, 0);
                    s1 = __builtin_amdgcn_mfma_f32_16x16x32_bf16(kf2, qf0, s1, 0, 0, 0);
                    s1 = __builtin_amdgcn_mfma_f32_16x16x32_bf16(kf3, qf1, s1, 0, 0, 0);
                    { const unsigned char* kn = kbase + (sl + 1 < nslab ? sl + 1 : sl) * 32 * 144;
                      kf0 = *(const bf16x8*)(kn); kf1 = *(const bf16x8*)(kn + 64); kf2 = *(const bf16x8*)(kn + 4 * 144); kf3 = *(const bf16x8*)(kn + 4 * 144 + 64); }
                    __builtin_amdgcn_sched_barrier(0);
                    float p[8];
#pragma unroll
                    for (int jj = 0; jj < 4; ++jj) { p[jj] = __builtin_amdgcn_exp2f(s0[jj]); p[4 + jj] = __builtin_amdgcn_exp2f(s1[jj]); }
                    if (own && sl == nslab - 1) {
#pragma unroll
                        for (int jj = 0; jj < 8; ++jj) if (sl * 32 + 8 * g + jj > qpos) p[jj] = 0.f; }
                    const u32x4 pk = pack8(p); const bf16x8 pb = __builtin_bit_cast(bf16x8, pk);
                    osum = __builtin_amdgcn_mfma_f32_16x16x32_bf16(vones, pb, osum, 0, 0, 0);
                    o[0] = __builtin_amdgcn_mfma_f32_16x16x32_bf16(vf0, pb, o[0], 0, 0, 0); o[1] = __builtin_amdgcn_mfma_f32_16x16x32_bf16(vf1, pb, o[1], 0, 0, 0);
                    o[2] = __builtin_amdgcn_mfma_f32_16x16x32_bf16(vf2, pb, o[2], 0, 0, 0); o[3] = __builtin_amdgcn_mfma_f32_16x16x32_bf16(vf3, pb, o[3], 0, 0, 0);
                }
                dsum = osum[0];
                if (valid) {
#pragma unroll
                    for (int dt = 0; dt < 4; ++dt) { f32x4* ap = (f32x4*)(acc + qi * 68 + dt * 16 + 4 * g); *ap = *ap + o[dt]; }
                    if (g == 0) acc[qi * 68 + 64] += dsum;
                }
            }
        }
        __syncthreads();
        { const int q = tid >> 1, hf = tid & 1; const float inv = 1.0f / acc[q * 68 + 64]; bf16_t* dst = yb + (tok0 + q) * 512 + h * 64 + hf * 32;
#pragma unroll
          for (int t8 = 0; t8 < 4; ++t8) { float f[8];
#pragma unroll
              for (int j = 0; j < 8; ++j) f[j] = acc[q * 68 + hf * 32 + t8 * 8 + j] * inv;
              *(u32x4*)(dst + t8 * 8) = pack8(f); } }
        __syncthreads();
    }
}

__device__ void phase_gn(const ScanBufs& S, const float* __restrict__ Oraw, bf16_t* __restrict__ ya, int bid, int nblk, const unsigned* prog) {
    const int lane = threadIdx.x & 63, gw = bid * 8 + (threadIdx.x >> 6), nw = nblk * 8;
    for (int task = gw; task < 32 * 128; task += nw) {
        const int seq = task & 31, t64 = task >> 5, s = t64 * 64 + lane, b = seq >> 3, h = seq & 7;
        if (prog) { const unsigned need = (unsigned)((t64 >> 4) + 1);
#pragma unroll
            for (int q = 0; q < 4; ++q) while (__hip_atomic_load(prog + (seq * 4 + q) * 16, __ATOMIC_RELAXED, __HIP_MEMORY_SCOPE_AGENT) < need) __builtin_amdgcn_s_sleep(8);
            __builtin_amdgcn_fence(__ATOMIC_ACQUIRE, "agent"); }
        float o[64]; float mean = 0.f;
#pragma unroll
        for (int v = 0; v < 64; ++v) { o[v] = Oraw[((size_t)seq * 64 + v) * SEQL + s]; mean += o[v]; }
        mean *= (1.0f / 64.0f); float var = 0.f;
#pragma unroll
        for (int v = 0; v < 64; ++v) { const float d = o[v] - mean; var += d * d; }
        const float rstd = rsqrtf(var * (1.0f / 64.0f) + 64e-5f);
        const size_t gb = ((size_t)seq * SEQL + s) * 64; bf16_t* dst = ya + ((size_t)b * SEQL + s) * 512 + h * 64;
#pragma unroll
        for (int t8 = 0; t8 < 8; ++t8) { const u32x4 a = *(const u32x4*)(S.g1 + gb + t8 * 8), c = *(const u32x4*)(S.g2 + gb + t8 * 8); float fa[8], fc[8], f[8]; unpack8(a, fa); unpack8(c, fc);
#pragma unroll
            for (int j = 0; j < 8; ++j) f[j] = (o[t8 * 8 + j] - mean) * rstd * fa[j] + fc[j];
            *(u32x4*)(dst + t8 * 8) = pack8(f); }
    }
}

__device__ void convert_bf16(const float* __restrict__ src, bf16_t* __restrict__ dst, size_t n8) {
    const size_t gtid = (size_t)blockIdx.x * 512 + threadIdx.x, gstride = (size_t)gridDim.x * 512;
    for (size_t i = gtid; i < n8; i += gstride) { const f32x4 a = *(const f32x4*)(src + i * 8), b = *(const f32x4*)(src + i * 8 + 4);
        u32x4 o; o.x = cvt_pk_bf16(a[0], a[1]); o.y = cvt_pk_bf16(a[2], a[3]); o.z = cvt_pk_bf16(b[0], b[1]); o.w = cvt_pk_bf16(b[2], b[3]); *(u32x4*)(dst + i * 8) = o; }
}

__device__ void convert_fp8(const float* __restrict__ src, unsigned char* __restrict__ dst, size_t n16, float scale, int bid, int nb) {
    const size_t gtid = (size_t)bid * 512 + threadIdx.x, gstride = (size_t)nb * 512;
    for (size_t i = gtid; i < n16; i += gstride) { u32x4 o;
#pragma unroll
        for (int q = 0; q < 4; ++q) { const f32x4 a = *(const f32x4*)(src + i * 16 + q * 4) * scale;
            int pk = __builtin_amdgcn_cvt_pk_fp8_f32(a[0], a[1], 0, false); pk = __builtin_amdgcn_cvt_pk_fp8_f32(a[2], a[3], pk, true); o[q] = (unsigned)pk; }
        *(u32x4*)(dst + i * 16) = o; }
}
__device__ __forceinline__ float dot16_fp8(const u32x4 u, const f32x2 (&hp)[8]) {
    const int w0 = (int)u.x, w1 = (int)u.y, w2 = (int)u.z, w3 = (int)u.w;
    f32x2 s = __builtin_amdgcn_cvt_pk_f32_fp8(w0, false) * hp[0]; s += __builtin_amdgcn_cvt_pk_f32_fp8(w0, true) * hp[1];
    s += __builtin_amdgcn_cvt_pk_f32_fp8(w1, false) * hp[2]; s += __builtin_amdgcn_cvt_pk_f32_fp8(w1, true) * hp[3];
    s += __builtin_amdgcn_cvt_pk_f32_fp8(w2, false) * hp[4]; s += __builtin_amdgcn_cvt_pk_f32_fp8(w2, true) * hp[5];
    s += __builtin_amdgcn_cvt_pk_f32_fp8(w3, false) * hp[6]; s += __builtin_amdgcn_cvt_pk_f32_fp8(w3, true) * hp[7];
    return s.x + s.y;
}
__device__ __forceinline__ void axpy16_fp8(f32x2 (&oa)[8], const u32x4 v, float a) {
    const int w0 = (int)v.x, w1 = (int)v.y, w2 = (int)v.z, w3 = (int)v.w;
    oa[0] += __builtin_amdgcn_cvt_pk_f32_fp8(w0, false) * a; oa[1] += __builtin_amdgcn_cvt_pk_f32_fp8(w0, true) * a;
    oa[2] += __builtin_amdgcn_cvt_pk_f32_fp8(w1, false) * a; oa[3] += __builtin_amdgcn_cvt_pk_f32_fp8(w1, true) * a;
    oa[4] += __builtin_amdgcn_cvt_pk_f32_fp8(w2, false) * a; oa[5] += __builtin_amdgcn_cvt_pk_f32_fp8(w2, true) * a;
    oa[6] += __builtin_amdgcn_cvt_pk_f32_fp8(w3, false) * a; oa[7] += __builtin_amdgcn_cvt_pk_f32_fp8(w3, true) * a;
}
__device__ __forceinline__ float gelu_erf(float v) {
    const float av = fabsf(v), t = 1.0f / (1.0f + 0.2316418882f * av);
    float q = t * 0.5307027145f + (-0.7265760135f); q = q * t + 0.7107068705f; q = q * t + (-0.142248368f); q = q * t + 0.127414796f; q = q * t;
    const float e = __expf(-0.5f * v * v); const float mm = v * (q * e); return v < 0.f ? mm : v - mm;
}
__device__ __forceinline__ float dot2u(unsigned a, unsigned b, float acc) { return __builtin_amdgcn_fdot2_f32_bf16(__builtin_bit_cast(bf2_t, a), __builtin_bit_cast(bf2_t, b), acc, false); }
__device__ __forceinline__ float dot16(const u32x4 a0, const u32x4 a1, const u32x4 h0, const u32x4 h1) {
    const unsigned ax = a0.x, ay = a0.y, az = a0.z, aw = a0.w, bx = a1.x, by = a1.y, bz = a1.z, bw = a1.w;
    const unsigned hx = h0.x, hy = h0.y, hz = h0.z, hw = h0.w, gx = h1.x, gy = h1.y, gz = h1.z, gw_ = h1.w;
    float s0 = 0.f, s1 = 0.f;
    s0 = dot2u(ax, hx, s0); s1 = dot2u(ay, hy, s1); s0 = dot2u(az, hz, s0); s1 = dot2u(aw, hw, s1);
    s0 = dot2u(bx, gx, s0); s1 = dot2u(by, gy, s1); s0 = dot2u(bz, gz, s0); s1 = dot2u(bw, gw_, s1);
    return s0 + s1;
}
__device__ __forceinline__ int top16_of_2(int x0, int x1, int li) {
    int sorted = 0; const int NEG = (int)0x80000000; const int l2 = (int)(threadIdx.x & 63) * 2;
#pragma unroll
    for (int r = 0; r < 16; ++r) { const int mx = wave_max_i(max(x0, x1)); const int widx = sortkey(mx) & 127;
        x0 = (widx == l2) ? NEG : x0; x1 = (widx == l2 + 1) ? NEG : x1;
        sorted = (li == r) ? mx : sorted; }
    return sorted;
}
__device__ __forceinline__ int rowmax_i(int x) {
    x = max(x, __builtin_amdgcn_mov_dpp(x, 0xB1, 0xF, 0xF, true)); x = max(x, __builtin_amdgcn_mov_dpp(x, 0x4E, 0xF, 0xF, true));
    x = max(x, __builtin_amdgcn_mov_dpp(x, 0x141, 0xF, 0xF, true)); x = max(x, __builtin_amdgcn_mov_dpp(x, 0x140, 0xF, 0xF, true)); return x;
}
#define PEER_CE(a, b) do { const int hi_ = max(k[a], k[b]), lo_ = min(k[a], k[b]); k[a] = hi_; k[b] = lo_; } while (0)
__device__ __forceinline__ int top16_rows(const u32x4 w, int li) {
    int k[8]; const int base = li * 8; const unsigned w0 = w.x, w1 = w.y, w2 = w.z, w3 = w.w;
    k[0] = sortkey((int)((w0 << 16) | (unsigned)(base + 0))); k[1] = sortkey((int)((w0 & 0xffff0000u) | (unsigned)(base + 1)));
    k[2] = sortkey((int)((w1 << 16) | (unsigned)(base + 2))); k[3] = sortkey((int)((w1 & 0xffff0000u) | (unsigned)(base + 3)));
    k[4] = sortkey((int)((w2 << 16) | (unsigned)(base + 4))); k[5] = sortkey((int)((w2 & 0xffff0000u) | (unsigned)(base + 5)));
    k[6] = sortkey((int)((w3 << 16) | (unsigned)(base + 6))); k[7] = sortkey((int)((w3 & 0xffff0000u) | (unsigned)(base + 7)));
    PEER_CE(0, 1); PEER_CE(2, 3); PEER_CE(4, 5); PEER_CE(6, 7); PEER_CE(0, 2); PEER_CE(1, 3); PEER_CE(4, 6); PEER_CE(5, 7); PEER_CE(1, 2); PEER_CE(5, 6);
    PEER_CE(0, 4); PEER_CE(1, 5); PEER_CE(2, 6); PEER_CE(3, 7); PEER_CE(2, 4); PEER_CE(3, 5); PEER_CE(1, 2); PEER_CE(3, 4); PEER_CE(5, 6);
    int sorted = 0; const int NEG = (int)0x80000000;
#pragma unroll
    for (int r = 0; r < 16; ++r) { const int m = rowmax_i(k[0]); const bool win = (k[0] == m);
        k[0] = win ? k[1] : k[0]; k[1] = win ? k[2] : k[1]; k[2] = win ? k[3] : k[2]; k[3] = win ? k[4] : k[3];
        k[4] = win ? k[5] : k[4]; k[5] = win ? k[6] : k[5]; k[6] = win ? k[7] : k[6]; k[7] = win ? NEG : k[7];
        sorted = (li == r) ? m : sorted; }
    return sorted;
}
__device__ __forceinline__ void axpy16(float (&oa)[16], const u32x4 v0, const u32x4 v1, float a) {
    oa[0] += a * bflo(v0.x); oa[1] += a * bfhi(v0.x); oa[2] += a * bflo(v0.y); oa[3] += a * bfhi(v0.y); oa[4] += a * bflo(v0.z); oa[5] += a * bfhi(v0.z); oa[6] += a * bflo(v0.w); oa[7] += a * bfhi(v0.w);
    oa[8] += a * bflo(v1.x); oa[9] += a * bfhi(v1.x); oa[10] += a * bflo(v1.y); oa[11] += a * bfhi(v1.y); oa[12] += a * bflo(v1.z); oa[13] += a * bfhi(v1.z); oa[14] += a * bflo(v1.w); oa[15] += a * bfhi(v1.w);
}
__device__ void phase_peer(const Params& P, const bf16_t* __restrict__ h2, const bf16_t* __restrict__ scores, const unsigned char* __restrict__ U8, const unsigned char* __restrict__ V8) {
    const int lane = threadIdx.x & 63, li = lane & 15, gw = blockIdx.x * 8 + (threadIdx.x >> 6), nw = gridDim.x * 8;
    const float* ada = (const float*)(P.ws + OFF_ADA);
    const unsigned ct = cand_tab[lane]; const int ca = ct >> 4, cb = ct & 15; const bool cvalid = ct != 0xffu;
    for (int t = gw; t < NTOK; t += nw) {
        const int b = t / SEQL;
        f32x2 hp[8];
        { const u32x4 hA = *(const u32x4*)(h2 + (size_t)t * DM + lane * 16), hB = *(const u32x4*)(h2 + (size_t)t * DM + lane * 16 + 8);
          hp[0] = (f32x2){bflo(hA.x), bfhi(hA.x)}; hp[1] = (f32x2){bflo(hA.y), bfhi(hA.y)}; hp[2] = (f32x2){bflo(hA.z), bfhi(hA.z)}; hp[3] = (f32x2){bflo(hA.w), bfhi(hA.w)};
          hp[4] = (f32x2){bflo(hB.x), bfhi(hB.x)}; hp[5] = (f32x2){bflo(hB.y), bfhi(hB.y)}; hp[6] = (f32x2){bflo(hB.z), bfhi(hB.z)}; hp[7] = (f32x2){bflo(hB.w), bfhi(hB.w)}; }
        f32x2 oa[8]; int srtP = 0;
#pragma unroll
        for (int j = 0; j < 8; ++j) oa[j] = (f32x2){0.f, 0.f};
        auto topk = [&](int hd, int& we, float& gwt) {
            if ((hd & 1) == 0) srtP = top16_rows(*(const u32x4*)(scores + (size_t)t * 2048 + (hd + (lane >> 5)) * 256 + ((lane >> 4) & 1) * 128 + li * 8), li);
            const int rb = (hd & 1) * 32;
            const int fa = sortkey(__shfl(srtP, rb + ca)), fb = sortkey(__shfl(srtP, rb + 16 + cb));
            const int eid = (fa & 127) * 128 + (fb & 127);
            int ck = cvalid ? sortkey((int)((__float_as_uint(__int_as_float(fa) + __int_as_float(fb)) & ~63u) | (unsigned)lane)) : (int)0x80000000;
            float wsc = 0.f; we = 0;
#pragma unroll
            for (int r = 0; r < 16; ++r) { const int mx = wave_max_i(ck); const int fm = sortkey(mx); const int wl = fm & 63;
                const int ee = __builtin_amdgcn_readlane(eid, wl);
                ck = (wl == lane) ? (int)0x80000000 : ck;
                wsc = (li == r) ? __int_as_float(fm) : wsc; we = (li == r) ? ee : we; }
            const float smax = __int_as_float(__builtin_amdgcn_readlane(__float_as_int(wsc), 0));
            const float ex = __expf(wsc - smax); gwt = ex / row_sum16(ex);
        };
        int we_c = 0; float gw_c = 0.f; topk(0, we_c, gw_c);
        u32x4 uu[16], vv_[16];
#pragma unroll
        for (int j = 0; j < 16; ++j) { const int e = __builtin_amdgcn_readlane(we_c, j); uu[j] = *(const u32x4*)(U8 + (size_t)e * DM + lane * 16); }
#pragma unroll 1
        for (int hd = 0; hd < 8; ++hd) {
#pragma unroll
            for (int j = 0; j < 16; ++j) { const int e = __builtin_amdgcn_readlane(we_c, j); vv_[j] = *(const u32x4*)(V8 + (size_t)e * DM + lane * 16); }
            __builtin_amdgcn_sched_barrier(0);
            int we_n = 0; float gw_n = 0.f;
            if (hd < 7) topk(hd + 1, we_n, gw_n);
            __builtin_amdgcn_sched_barrier(0);
            float pd[16];
#pragma unroll
            for (int j = 0; j < 16; ++j) pd[j] = dot16_fp8(uu[j], hp);
            float q8[8];
            { const bool hi = (li & 8) != 0;
#pragma unroll
              for (int j = 0; j < 8; ++j) { const float send = hi ? pd[j] : pd[j + 8], keep = hi ? pd[j + 8] : pd[j]; q8[j] = keep + dppf0<0x140>(send); } }
            float q4[4];
            { const bool hi = (li & 4) != 0;
#pragma unroll
              for (int j = 0; j < 4; ++j) { const float send = hi ? q8[j] : q8[j + 4], keep = hi ? q8[j + 4] : q8[j]; q4[j] = keep + dppf0<0x141>(send); } }
            float q2[2];
            { const bool hi = (li & 2) != 0;
#pragma unroll
              for (int j = 0; j < 2; ++j) { const float send = hi ? q4[j] : q4[j + 2], keep = hi ? q4[j + 2] : q4[j]; q2[j] = keep + dppf0<0x1B>(send); } }
            float dsum;
            { const bool hi = (li & 1) != 0; const float send = hi ? q2[0] : q2[1], keep = hi ? q2[1] : q2[0]; dsum = keep + dppf0<0xB1>(send); }
            dsum += __shfl_xor(dsum, 16); dsum += __shfl_xor(dsum, 32);
            const float act = gelu_erf(dsum * (1.0f / 32.0f)) * gw_c * (1.0f / 16.0f);
            __builtin_amdgcn_sched_barrier(0);
            if (hd < 7) {
#pragma unroll
                for (int j = 0; j < 16; ++j) { const int e = __builtin_amdgcn_readlane(we_n, j); uu[j] = *(const u32x4*)(U8 + (size_t)e * DM + lane * 16); } }
            __builtin_amdgcn_sched_barrier(0);
#pragma unroll
            for (int j = 0; j < 16; ++j) { const float a = __int_as_float(__builtin_amdgcn_readlane(__float_as_int(act), j)); axpy16_fp8(oa, vv_[j], a); }
            we_c = we_n; gw_c = gw_n;
        }
        float* op = P.out + (size_t)t * DM + lane * 16; const float* g2p = ada + b * 6144 + 5120 + lane * 16;
#pragma unroll
        for (int q = 0; q < 4; ++q) { const f32x4 xv = *(const f32x4*)(op + q * 4), gv = *(const f32x4*)(g2p + q * 4);
            f32x4 r; r[0] = xv[0] + gv[0] * oa[q * 2].x; r[1] = xv[1] + gv[1] * oa[q * 2].y; r[2] = xv[2] + gv[2] * oa[q * 2 + 1].x; r[3] = xv[3] + gv[3] * oa[q * 2 + 1].y;
            *(f32x4*)(op + q * 4) = r; }
    }
}

__device__ __forceinline__ void gbar(unsigned* ctr, unsigned target) {
    __syncthreads();
    if (threadIdx.x == 0) {
        __builtin_amdgcn_fence(__ATOMIC_RELEASE, "agent");
        __hip_atomic_fetch_add(ctr, 1u, __ATOMIC_RELAXED, __HIP_MEMORY_SCOPE_AGENT);
        while (__hip_atomic_load(ctr, __ATOMIC_RELAXED, __HIP_MEMORY_SCOPE_AGENT) < target) __builtin_amdgcn_s_sleep(2);
        __builtin_amdgcn_fence(__ATOMIC_ACQUIRE, "agent");
        asm volatile("s_waitcnt vmcnt(0)" ::: "memory");
    }
    __syncthreads();
}
__global__ void __launch_bounds__(512) fwd_megakernel(Params P) {
    extern __shared__ __attribute__((aligned(16))) unsigned char smem[];
    cg::grid_group grid = cg::this_grid();
    unsigned char* ws = P.ws; PG8_LAS unsigned char* lds = (PG8_LAS unsigned char*)smem;
    bf16_t* hbf = (bf16_t*)(ws + OFF_HBF); bf16_t* projR = (bf16_t*)(ws + OFF_PR); bf16_t* projM = (bf16_t*)(ws + OFF_PM); bf16_t* projG = (bf16_t*)(ws + OFF_PG);
    float* ada = (float*)(ws + OFF_ADA);
    ScanBufs S; S.sr = hbf; S.sw = hbf + (size_t)NTOK * 512; S.sk = (bf16_t*)(ws + OFF_FREE); S.sv = S.sk + (size_t)NTOK * 512;
    S.skk = (bf16_t*)P.out; S.sb = S.skk + (size_t)NTOK * 512; S.g1 = S.sb + (size_t)NTOK * 512; S.g2 = S.g1 + (size_t)NTOK * 512;
    float* Oraw = (float*)projR; bf16_t* ya = projR + (size_t)NTOK * 1024; bf16_t* yb = ya + (size_t)NTOK * 512; bf16_t* t0 = projM; bf16_t* mix = hbf;
    bf16_t* h2 = projR + (size_t)NTOK * 1024; bf16_t* scores = projG; unsigned char* U8 = (unsigned char*)projM + 64 * MIB; unsigned char* V8 = U8 + (size_t)16384 * 1024;
    StaticOrder so; unsigned* bar = (unsigned*)(ws + OFF_CTL);

    phase0_ada(P, smem);
    grid.sync();
    phase_norm(P.x, P.norm1_g, ada, 0, 1024, hbf);
    phase0_weights(P);
    gbar(bar, 1u * gridDim.x);
    { Gemm g{hbf, (const bf16_t*)(ws + OFF_WIN), NTOK, 5632, 1024}; so.init(NTOK, 5632, gridDim.x, blockIdx.x); EpiProj e{projR, projM, projG}; gemm_phase(lds, g, so, e, nullptr); }
    gbar(bar, 2u * gridDim.x);
    phase_rwkv_prep(P, S, smem);
    __syncthreads();
    phase_moba_prep(P, smem);
    gbar(bar, 3u * gridDim.x);
    { const int nscan = gridDim.x >= 256 ? 128 : gridDim.x;
      if ((int)blockIdx.x < nscan) phase_scan(P, S, Oraw, smem, blockIdx.x, nscan, bar + 512);
      phase_moba(P, yb, smem, bar + 16, bar + 160);
      const int ebase = gridDim.x >= 256 ? nscan : 0, enb = (int)gridDim.x - ebase;
      if ((int)blockIdx.x >= ebase) {
          if (threadIdx.x == 0) { while (__hip_atomic_load(bar + 160, __ATOMIC_RELAXED, __HIP_MEMORY_SCOPE_AGENT) < 1024u) __builtin_amdgcn_s_sleep(8);
              __builtin_amdgcn_fence(__ATOMIC_ACQUIRE, "agent"); asm volatile("s_waitcnt vmcnt(0)" ::: "memory"); }
          __syncthreads();
          so.init(NTOK, 1024, enb, (int)blockIdx.x - ebase);
          Gemm gb{yb, (const bf16_t*)(ws + OFF_WBR) + 1024 * 512, NTOK, 1024, 512}; EpiMerge<0, 1024> eb{projG, t0, mix}; gemm_phase(lds, gb, so, eb, nullptr);
          convert_fp8(P.peer_u, U8, (size_t)16384 * 1024 / 16, 32.0f, (int)blockIdx.x - ebase, enb);
          convert_fp8(P.peer_v, V8, (size_t)16384 * 1024 / 16, 16.0f, (int)blockIdx.x - ebase, enb);
          __syncthreads();
          phase0_weights_late(P, smem, (int)blockIdx.x - ebase, enb);
          phase_gn(S, Oraw, ya, (int)blockIdx.x - ebase, enb, bar + 512);
      } }
    gbar(bar, 4u * gridDim.x);
    { so.init(NTOK, 1024, gridDim.x, blockIdx.x); Gemm ga{ya, (const bf16_t*)(ws + OFF_WBR), NTOK, 1024, 512}; EpiMerge<1, 0> ea{projG, t0, mix}; gemm_phase(lds, ga, so, ea, nullptr); }
    gbar(bar, 5u * gridDim.x);
    { so.init(NTOK, 1024, gridDim.x, blockIdx.x); Gemm g{mix, (const bf16_t*)(ws + OFF_WOUT), NTOK, 1024, 1024}; EpiOut e{P.x, ada, P.out}; gemm_phase(lds, g, so, e, nullptr); }
    gbar(bar, 6u * gridDim.x);
    phase_norm(P.out, P.norm2_g, ada, 3072, 4096, h2);
    gbar(bar, 7u * gridDim.x);
    { so.init(NTOK, 2048, gridDim.x, blockIdx.x); Gemm g{h2, (const bf16_t*)(ws + OFF_WC), NTOK, 2048, 1024}; EpiScore e{scores}; gemm_phase(lds, g, so, e, nullptr); }
    gbar(bar, 8u * gridDim.x);
    phase_peer(P, h2, scores, U8, V8);
}

extern "C" void kernel_launch(void* const* d_in, const int* in_sizes, int n_in, void* d_out, int out_size, void* d_ws, size_t ws_size, hipStream_t stream) {
    static int grid = 0;
    if (grid == 0) {
        int dev = 0, cus = 0, per_cu = 0;
        hipGetDevice(&dev); hipDeviceGetAttribute(&cus, hipDeviceAttributeMultiprocessorCount, dev);
        hipFuncSetAttribute((const void*)fwd_megakernel, hipFuncAttributeMaxDynamicSharedMemorySize, LDS_BYTES);
        hipOccupancyMaxActiveBlocksPerMultiprocessor(&per_cu, (const void*)fwd_megakernel, 512, LDS_BYTES);
        (void)hipGetLastError();
        if (per_cu < 1) per_cu = 1;
        grid = cus > 0 ? cus : 256;
    }
    (void)hipMemsetAsync((char*)d_ws + OFF_CTL, 0, 16384, stream);
    Params p{};
    const float** f = (const float**)&p;
    for (int i = 0; i < 26; ++i) f[i] = (const float*)d_in[i];
    p.out = (float*)d_out; p.ws = (unsigned char*)d_ws;
    void* args[] = {&p};
    hipError_t e = hipLaunchCooperativeKernel((const void*)fwd_megakernel, dim3(grid), dim3(512), args, LDS_BYTES, stream);
    if (e != hipSuccess) fprintf(stderr, "cooperative launch failed: %s (grid %d)\n", hipGetErrorString(e), grid);
}
```

```cpp
#include <hip/hip_runtime.h>
#include <hip/hip_cooperative_groups.h>
#include <cstdio>
namespace cg = cooperative_groups;
namespace pg8 {
#define PG8_LAS __attribute__((address_space(3)))
typedef unsigned short bf16_t;
typedef short bf16x8 __attribute__((ext_vector_type(8)));
typedef float f32x4 __attribute__((ext_vector_type(4)));
typedef unsigned u32x4 __attribute__((ext_vector_type(4)));
constexpr int BM = 256, BK = 64, HALF = 128, HTB = HALF * BK * 2  , STAGE_BYTES = 8 * HTB, NXCD = 8, WGM = 8;

__host__ __device__ __forceinline__ int lds_byte(int r, int c) { const int st = (r >> 4) * 2 + (c >> 5), rr = r & 15, cc = c & 31, ob = rr * 64 + cc * 2; return st * 1024 + (ob ^ (((ob >> 9) & 1) << 5)); }
__host__ __device__ __forceinline__ void stage_rc(int b, int& R, int& C) { const int st = b / 1024, sb = b % 1024, swz = sb ^ (((sb >> 9) & 1) << 5); R = (st >> 1) * 16 + swz / 64; C = (st & 1) * 32 + (swz % 64) / 2; }
__host__ __device__ __forceinline__ int perm32(int rho) { const int n = rho >> 4, i = rho & 15; return 8 * (i >> 2) + 4 * n + (i & 3); }

struct Unit { int pm, pn; };
struct Gemm { const bf16_t* A; const bf16_t* Bt; int M, N, K; };

struct StaticOrder {
    int nM, nN, nwg, G, c;
    __host__ __device__ void init(int M, int N, int G_, int c_) { nM = M / BM; nN = N / BM; nwg = nM * nN; G = G_; c = c_; }
    __host__ __device__ bool next(int i, Unit& u) const {
        const long L = (long)i * G + c; if (L >= nwg) return false;
        int wgid = (int)L; { const int q = nwg / NXCD, r = nwg % NXCD, xcd = wgid % NXCD, off = wgid / NXCD; wgid = (xcd < r ? xcd * (q + 1) : r * (q + 1) + (xcd - r) * q) + off; }
        const int nig = WGM * nN, gid = wgid / nig, fm = gid * WGM, gsz = (nM - fm) < WGM ? (nM - fm) : WGM;
        u.pm = fm + ((wgid % nig) % gsz); u.pn = (wgid % nig) / gsz; return true;
    }
    __device__ __forceinline__ void a_ready(const Unit&) const {}
    __device__ __forceinline__ void done(const Unit&) const {}
};
__device__ __forceinline__ unsigned cvt_pk_bf16(float lo, float hi) { unsigned r; asm volatile("v_cvt_pk_bf16_f32 %0, %1, %2" : "=v"(r) : "v"(lo), "v"(hi)); return r; }
typedef float f32x2 __attribute__((ext_vector_type(2)));
template <class Epi, class Sched, bool STAMP = false>
__device__ __forceinline__ void gemm_phase(PG8_LAS unsigned char* lds, const Gemm g, const Sched& S, const Epi& E, unsigned long long* stamps) {
    int tid_ = threadIdx.x; asm volatile("" : "+v"(tid_));
    const int tid = tid_, wid = __builtin_amdgcn_readfirstlane(tid >> 6), lane = tid & 63, wr = wid >> 2, wc = wid & 3, fr = lane & 15, fq = lane >> 4;
    const int K = g.K, nt = K / BK;
    int ts_lo = 0, ts_hi = 0, nts = 0; const unsigned long long rt_entry = STAMP ? (unsigned long long)wall_clock64() : 0ull;
#define PG8_STAMP() do { if (STAMP && wid == 0 && nts < 64) { const unsigned long long _c = (unsigned long long)clock64(); \
        ts_lo = (lane == nts) ? (int)(unsigned)_c : ts_lo; ts_hi = (lane == nts) ? (int)(unsigned)(_c >> 32) : ts_hi; ++nts; } } while (0)
    PG8_STAMP();
    unsigned voffA[2], voffB[2];
#pragma unroll
    for (int i = 0; i < 2; ++i) { int R, C; stage_rc(tid * 16 + i * 8192, R, C); const int Rb = Epi::PERM ? ((R & ~31) + perm32(R & 31)) : R;
        voffA[i] = (unsigned)(R * K + C) * 2u; voffB[i] = (unsigned)(Rb * K + C) * 2u; }
    const size_t kstep = (size_t)(BK * 2);
    const size_t hstep = (size_t)HALF * K * 2;
    const size_t tstep = 2 * hstep;
    const unsigned ldsw = (unsigned)wid * 1024u;
    const int aoff = lds_byte(wr * 64 + fr, fq * 8), boff = lds_byte(wc * 32 + fr, fq * 8);
#define PG8_SA(b, h) (((b) * 2 + (h)) * HTB)
#define PG8_SB(b, h) ((4 + (b) * 2 + (h)) * HTB)
#define PG8_STAGE(bufoff, gbase, voff) do { _Pragma("unroll") for (int _i = 0; _i < 2; ++_i) \
        __builtin_amdgcn_global_load_lds((const unsigned*)((const char*)(gbase) + (voff)[_i]), (PG8_LAS unsigned*)(lds + (bufoff) + ldsw + _i * 8192), 16, 0, 0); } while (0)
#define PG8_LDA(dst, b, h) do { _Pragma("unroll") for (int m = 0; m < 4; ++m) _Pragma("unroll") for (int k = 0; k < 2; ++k) dst[m][k] = *(const PG8_LAS bf16x8*)(lds + PG8_SA(b, h) + aoff + m * 2048 + k * 1024); } while (0)
#define PG8_LDB(dst, b, h) do { _Pragma("unroll") for (int n = 0; n < 2; ++n) _Pragma("unroll") for (int k = 0; k < 2; ++k) dst[n][k] = *(const PG8_LAS bf16x8*)(lds + PG8_SB(b, h) + boff + n * 2048 + k * 1024); } while (0)
#define PG8_MMA(ai, bj, At, Bt) do { __builtin_amdgcn_s_setprio(1); _Pragma("unroll") for (int m = 0; m < 4; ++m) _Pragma("unroll") for (int n = 0; n < 2; ++n) _Pragma("unroll") for (int k = 0; k < 2; ++k) \
        acc[ai][bj][m][n] = __builtin_amdgcn_mfma_f32_16x16x32_bf16(Bt[n][k], At[m][k], acc[ai][bj][m][n], 0, 0, 0); __builtin_amdgcn_s_setprio(0); } while (0)
#define PG8_WAIT_V(n) asm volatile("s_waitcnt vmcnt(" #n ")" ::: "memory")
#define PG8_WAIT_L(n) asm volatile("s_waitcnt lgkmcnt(" #n ")" ::: "memory")
#define PG8_BAR __builtin_amdgcn_s_barrier()
#define PG8_SCHED __builtin_amdgcn_sched_barrier(0)
    Unit cur, nxt; int ui = 0;
    if (!S.next(0, cur)) return;
    f32x4 acc[2][2][4][2];
#pragma unroll
    for (int a = 0; a < 2; ++a)
#pragma unroll
        for (int b = 0; b < 2; ++b)
#pragma unroll
            for (int m = 0; m < 4; ++m)
#pragma unroll
                for (int n = 0; n < 2; ++n) acc[a][b][m][n] = (f32x4){0.f, 0.f, 0.f, 0.f};
    bf16x8 At[4][2], B0[2][2], B1[2][2];
    const char* cA = (const char*)g.A + (size_t)cur.pm * tstep; const char* cB = (const char*)g.Bt + (size_t)cur.pn * tstep;
    S.a_ready(cur);
    PG8_STAGE(PG8_SB(0, 0), cB, voffB); PG8_STAGE(PG8_SA(0, 0), cA, voffA); PG8_STAGE(PG8_SB(0, 1), cB + hstep, voffB); PG8_STAGE(PG8_SA(0, 1), cA + hstep, voffA);
    if (wr == 1) PG8_BAR;
    PG8_WAIT_V(4); PG8_BAR;
    PG8_STAGE(PG8_SB(1, 0), cB + kstep, voffB); PG8_STAGE(PG8_SA(1, 0), cA + kstep, voffA); PG8_STAGE(PG8_SB(1, 1), cB + hstep + kstep, voffB);
    PG8_WAIT_V(6); PG8_BAR;
    PG8_STAMP();
    for (;;) {
        const bool has_next = S.next(ui + 1, nxt);
        const char* nA = has_next ? (const char*)g.A + (size_t)nxt.pm * tstep : cA; const char* nB = has_next ? (const char*)g.Bt + (size_t)nxt.pn * tstep : cB;
        for (int t = 0; t < nt; t += 2) {
            const bool last = (t == nt - 2);
            const char* a1 = cA + (size_t)(t + 1) * kstep;
            const char* a2 = last ? nA : cA + (size_t)(t + 2) * kstep; const char* b2 = last ? nB : cB + (size_t)(t + 2) * kstep;
            const char* a3 = a2 + kstep; const char* b3 = b2 + kstep;
            if (last && has_next) S.a_ready(nxt);
            PG8_LDB(B0, 0, 0); PG8_SCHED; PG8_LDA(At, 0, 0); PG8_STAGE(PG8_SA(1, 1), a1 + hstep, voffA);
            PG8_WAIT_L(8); PG8_BAR; PG8_WAIT_L(0); PG8_MMA(0, 0, At, B0); PG8_BAR; PG8_SCHED;
            PG8_LDB(B1, 0, 1); PG8_STAGE(PG8_SB(0, 0), b2, voffB);
            PG8_BAR; PG8_WAIT_L(0); PG8_MMA(0, 1, At, B1); PG8_BAR;
            PG8_LDA(At, 0, 1); PG8_STAGE(PG8_SA(0, 0), a2, voffA);
            PG8_BAR; PG8_WAIT_L(0); PG8_MMA(1, 0, At, B0); PG8_BAR; PG8_SCHED;
            PG8_STAGE(PG8_SB(0, 1), b2 + hstep, voffB);
            PG8_WAIT_V(6); PG8_BAR; PG8_MMA(1, 1, At, B1); PG8_BAR;
            PG8_LDB(B0, 1, 0); PG8_SCHED; PG8_LDA(At, 1, 0); PG8_STAGE(PG8_SA(0, 1), a2 + hstep, voffA);
            PG8_WAIT_L(8); PG8_BAR; PG8_WAIT_L(0); PG8_MMA(0, 0, At, B0); PG8_BAR; PG8_SCHED;
            PG8_LDB(B1, 1, 1); PG8_STAGE(PG8_SB(1, 0), b3, voffB);
            PG8_BAR; PG8_WAIT_L(0); PG8_MMA(0, 1, At, B1); PG8_BAR;
            PG8_LDA(At, 1, 1); PG8_STAGE(PG8_SA(1, 0), a3, voffA);
            PG8_BAR; PG8_WAIT_L(0); PG8_MMA(1, 0, At, B0); PG8_BAR; PG8_SCHED;
            PG8_STAGE(PG8_SB(1, 1), b3 + hstep, voffB);
            PG8_WAIT_V(6); PG8_BAR; PG8_MMA(1, 1, At, B1); PG8_BAR;
        }
        PG8_STAMP();
        if constexpr (!Epi::AFTER_DRAIN) { E(acc, cur, wr, wc, fr, fq); S.done(cur); }
        PG8_STAMP();
        if (!has_next) break;
#pragma unroll
        for (int a = 0; a < 2; ++a)
#pragma unroll
            for (int b = 0; b < 2; ++b)
#pragma unroll
                for (int m = 0; m < 4; ++m)
#pragma unroll
                    for (int n = 0; n < 2; ++n) acc[a][b][m][n] = (f32x4){0.f, 0.f, 0.f, 0.f};
        cur = nxt; cA = nA; cB = nB; ++ui;
    }
    PG8_WAIT_V(0);
    if (wr == 0) PG8_BAR;
    PG8_BAR;
    if constexpr (Epi::AFTER_DRAIN) { E.fused(acc, cur, wr, wc, fr, fq, lds, wid, lane); S.done(cur); }
    PG8_STAMP();
    if (STAMP && wid == 0) { stamps[lane] = lane < nts ? (((unsigned long long)(unsigned)ts_hi << 32) | (unsigned)ts_lo) : 0ull;
        if (lane == 62) stamps[62] = rt_entry; if (lane == 63) stamps[63] = (unsigned long long)wall_clock64(); }
#undef PG8_STAMP
#undef PG8_SA
#undef PG8_SB
#undef PG8_STAGE
#undef PG8_LDA
#undef PG8_LDB
#undef PG8_MMA
#undef PG8_WAIT_V
#undef PG8_WAIT_L
#undef PG8_BAR
#undef PG8_SCHED
}
}
using namespace pg8;
#define GSYNC() grid.sync()
typedef unsigned u32x2 __attribute__((ext_vector_type(2)));
typedef __bf16 bf2_t __attribute__((ext_vector_type(2)));

constexpr int NTOK = 32768, SEQL = 8192, DM = 1024;
constexpr size_t MIB = 1ull << 20;
constexpr size_t OFF_WIN = 0, OFF_WBR = 11 * MIB, OFF_WOUT = 13 * MIB, OFF_WC = 15 * MIB, OFF_LORA = 19 * MIB,
                 OFF_ADA = 19 * MIB + 512 * 1024, OFF_KMEAN = 19 * MIB + 640 * 1024, OFF_HBF = 20 * MIB, OFF_PR = 84 * MIB,
                 OFF_PM = 212 * MIB, OFF_PG = 308 * MIB, OFF_FREE = 436 * MIB;
constexpr size_t OFF_CTL = 19 * MIB + 896 * 1024;
constexpr int LDS_BYTES = 150528;

struct Params {
    const float *x, *c, *w_ada, *b_ada, *norm1_g, *w_in, *mu, *w0, *w2_decay, *a0, *a2_iclr, *g2_gate, *k_k, *k_a, *r_k, *lnx_w, *lnx_b,
                *q_norm_g, *k_norm_g, *w_branch, *w_out, *norm2_g, *w_peer_q, *sub_keys, *peer_u, *peer_v;
    float* out; unsigned char* ws;
};

__constant__ unsigned char cand_tab[64] = {
    0x00,0x01,0x02,0x03,0x04,0x05,0x06,0x07,0x08,0x09,0x0a,0x0b,0x0c,0x0d,0x0e,0x0f,
    0x10,0x11,0x12,0x13,0x14,0x15,0x16,0x17,
    0x20,0x21,0x22,0x23,0x24,
    0x30,0x31,0x32,0x33,
    0x40,0x41,0x42,
    0x50,0x51, 0x60,0x61, 0x70,0x71,
    0x80,0x90,0xa0,0xb0,0xc0,0xd0,0xe0,0xf0,
    0xff,0xff,0xff,0xff,0xff,0xff,0xff,0xff,0xff,0xff,0xff,0xff,0xff,0xff};

__device__ __forceinline__ float bflo(unsigned u) { return __uint_as_float(u << 16); }
__device__ __forceinline__ float bfhi(unsigned u) { return __uint_as_float(u & 0xffff0000u); }
__device__ __forceinline__ float sigmoidf_(float x) { return __builtin_amdgcn_rcpf(1.0f + __expf(-x)); }
template <int CTRL, int RM = 0xF>
__device__ __forceinline__ float dppf(float x) { return __int_as_float(__builtin_amdgcn_update_dpp(__float_as_int(x), __float_as_int(x), CTRL, RM, 0xF, false)); }
template <int CTRL>
__device__ __forceinline__ float dppf0(float x) { return __int_as_float(__builtin_amdgcn_update_dpp(0, __float_as_int(x), CTRL, 0xF, 0xF, false)); }
__device__ __forceinline__ float row_sum16(float x) { x += dppf0<0xB1>(x); x += dppf0<0x4E>(x); x += dppf0<0x141>(x); x += dppf0<0x140>(x); return x; }
__device__ __forceinline__ float wave_max(float x) {
    x = fmaxf(x, dppf<0xB1>(x)); x = fmaxf(x, dppf<0x4E>(x)); x = fmaxf(x, dppf<0x141>(x)); x = fmaxf(x, dppf<0x140>(x));
    x = fmaxf(x, dppf<0x142, 0xA>(x)); x = fmaxf(x, dppf<0x143, 0xC>(x));
    return __int_as_float(__builtin_amdgcn_readlane(__float_as_int(x), 63));
}
__device__ __forceinline__ int sortkey(int f) { return f ^ ((f >> 31) & 0x7fffffff); }
template <int CTRL, int RM = 0xF>
__device__ __forceinline__ int dppi(int x) { return __builtin_amdgcn_update_dpp(x, x, CTRL, RM, 0xF, false); }
__device__ __forceinline__ int wave_max_i(int x) {
    x = max(x, __builtin_amdgcn_mov_dpp(x, 0xB1, 0xF, 0xF, true)); x = max(x, __builtin_amdgcn_mov_dpp(x, 0x4E, 0xF, 0xF, true));
    x = max(x, __builtin_amdgcn_mov_dpp(x, 0x141, 0xF, 0xF, true)); x = max(x, __builtin_amdgcn_mov_dpp(x, 0x140, 0xF, 0xF, true));
    x = max(x, dppi<0x142, 0xA>(x)); x = max(x, dppi<0x143, 0xC>(x));
    return __builtin_amdgcn_readlane(x, 63);
}
__device__ __forceinline__ void unpack8(const u32x4 v, float (&f)[8]) {
    f[0] = bflo(v.x); f[1] = bfhi(v.x); f[2] = bflo(v.y); f[3] = bfhi(v.y); f[4] = bflo(v.z); f[5] = bfhi(v.z); f[6] = bflo(v.w); f[7] = bfhi(v.w);
}
__device__ __forceinline__ u32x4 pack8(const float (&f)[8]) {
    u32x4 o; o.x = cvt_pk_bf16(f[0], f[1]); o.y = cvt_pk_bf16(f[2], f[3]); o.z = cvt_pk_bf16(f[4], f[5]); o.w = cvt_pk_bf16(f[6], f[7]); return o;
}

struct EpiProj {
    static constexpr bool PERM = true, AFTER_DRAIN = false;
    bf16_t *pr, *pm, *pg;
    __device__ __forceinline__ void operator()(const f32x4 (&acc)[2][2][4][2], const Unit& u, int wr, int wc, int fr, int fq) const {
        const int row0 = u.pm * BM + wr * 64 + fr; bf16_t* base; int ldc, colt; bool sig = false;
        if (u.pn < 8) { base = pr; ldc = 2048; colt = u.pn * 256; } else if (u.pn < 14) { base = pm; ldc = 1536; colt = (u.pn - 8) * 256; } else { base = pg; ldc = 2048; colt = (u.pn - 14) * 256; sig = true; }
        const int col0 = colt + wc * 32 + 8 * fq;
#pragma unroll
        for (int ai = 0; ai < 2; ++ai)
#pragma unroll
            for (int m = 0; m < 4; ++m) { bf16_t* rowp = base + (size_t)(row0 + ai * HALF + m * 16) * ldc + col0;
#pragma unroll
                for (int bj = 0; bj < 2; ++bj) { f32x4 v0 = acc[ai][bj][m][0], v1 = acc[ai][bj][m][1];
                    if (sig) {
#pragma unroll
                        for (int j = 0; j < 4; ++j) { v0[j] = sigmoidf_(v0[j]); v1[j] = sigmoidf_(v1[j]); } }
                    u32x4 w; w.x = cvt_pk_bf16(v0[0], v0[1]); w.y = cvt_pk_bf16(v0[2], v0[3]); w.z = cvt_pk_bf16(v1[0], v1[1]); w.w = cvt_pk_bf16(v1[2], v1[3]);
                    *(u32x4*)(rowp + bj * HALF) = w; } }
    }
};
template <int WHICH, int GOFF> struct EpiMerge {
    static constexpr bool PERM = true, AFTER_DRAIN = false;
    const bf16_t* gates; bf16_t* t0; bf16_t* mix;
    __device__ __forceinline__ void operator()(const f32x4 (&acc)[2][2][4][2], const Unit& u, int wr, int wc, int fr, int fq) const {
        const int row0 = u.pm * BM + wr * 64 + fr, col0 = u.pn * BM + wc * 32 + 8 * fq;
#pragma unroll
        for (int ai = 0; ai < 2; ++ai)
#pragma unroll
            for (int m = 0; m < 4; ++m) { const size_t row = (size_t)(row0 + ai * HALF + m * 16);
#pragma unroll
                for (int bj = 0; bj < 2; ++bj) { const int c = col0 + bj * HALF;
                    const u32x4 gv = *(const u32x4*)(gates + row * 2048 + GOFF + c); float g[8]; unpack8(gv, g);
                    const f32x4 v0 = acc[ai][bj][m][0], v1 = acc[ai][bj][m][1]; float r[8];
#pragma unroll
                    for (int j = 0; j < 4; ++j) { r[j] = g[j] * v0[j]; r[4 + j] = g[4 + j] * v1[j]; }
                    if (WHICH == 1) { const u32x4 tv = *(const u32x4*)(t0 + row * 1024 + c); float t[8]; unpack8(tv, t);
#pragma unroll
                        for (int j = 0; j < 8; ++j) r[j] += t[j];
                        *(u32x4*)(mix + row * 1024 + c) = pack8(r); }
                    else *(u32x4*)(t0 + row * 1024 + c) = pack8(r); } }
    }
};
struct EpiOut {
    static constexpr bool PERM = false, AFTER_DRAIN = false;
    const float* x; const float* ada; float* out;
    __device__ __forceinline__ void operator()(const f32x4 (&acc)[2][2][4][2], const Unit& u, int wr, int wc, int fr, int fq) const {
        const int row0 = u.pm * BM + wr * 64 + fr, col0 = u.pn * BM + wc * 32 + 4 * fq; const int b = (u.pm * BM) / SEQL;
        f32x4 gv[2][2];
#pragma unroll
        for (int bj = 0; bj < 2; ++bj)
#pragma unroll
            for (int n = 0; n < 2; ++n) gv[bj][n] = *(const f32x4*)(ada + b * 6144 + 2048 + col0 + bj * HALF + n * 16);
#pragma unroll
        for (int ai = 0; ai < 2; ++ai)
#pragma unroll
            for (int m = 0; m < 4; ++m) { const size_t off = (size_t)(row0 + ai * HALF + m * 16) * DM + col0;
#pragma unroll
                for (int bj = 0; bj < 2; ++bj)
#pragma unroll
                    for (int n = 0; n < 2; ++n) { const f32x4 xv = *(const f32x4*)(x + off + bj * HALF + n * 16);
                        *(f32x4*)(out + off + bj * HALF + n * 16) = xv + gv[bj][n] * acc[ai][bj][m][n]; } }
    }
};
struct EpiScore {
    static constexpr bool PERM = true, AFTER_DRAIN = false;
    bf16_t* O;
    __device__ __forceinline__ void operator()(const f32x4 (&acc)[2][2][4][2], const Unit& u, int wr, int wc, int fr, int fq) const {
        const int row0 = u.pm * BM + wr * 64 + fr, col0 = u.pn * BM + wc * 32 + 8 * fq;
#pragma unroll
        for (int ai = 0; ai < 2; ++ai)
#pragma unroll
            for (int m = 0; m < 4; ++m) { bf16_t* rowp = O + (size_t)(row0 + ai * HALF + m * 16) * 2048 + col0;
#pragma unroll
                for (int bj = 0; bj < 2; ++bj) { const f32x4 v0 = acc[ai][bj][m][0], v1 = acc[ai][bj][m][1];
                    u32x4 w; w.x = cvt_pk_bf16(v0[0], v0[1]); w.y = cvt_pk_bf16(v0[2], v0[3]); w.z = cvt_pk_bf16(v1[0], v1[1]); w.w = cvt_pk_bf16(v1[2], v1[3]);
                    *(u32x4*)(rowp + bj * HALF) = w; } }
    }
};

template <int MODE>
__device__ __forceinline__ void transpose_bf16(const float* __restrict__ W, int K, int Nsrc, bf16_t* __restrict__ Bt, int Nout, size_t gtid, size_t gstride) {
    const size_t total = (size_t)Nout * (K / 8);
    for (size_t it = gtid; it < total; it += gstride) {
        const int n = (int)(it % Nout), k8 = (int)(it / Nout);
        int src = n; if (MODE == 1) src = n < 1824 ? n : (n < 2048 ? -1 : n - 224);
        u32x4 o = {0u, 0u, 0u, 0u};
        if (src >= 0) { const float* p = W + (size_t)(k8 * 8) * Nsrc + src; float v[8];
#pragma unroll
            for (int j = 0; j < 8; ++j) v[j] = p[(size_t)j * Nsrc];
            o = pack8(v); }
        *(u32x4*)(Bt + (size_t)n * K + k8 * 8) = o;
    }
}

__device__ void phase0_ada(const Params& P, unsigned char* smem) {
    const int tid = threadIdx.x, wid = tid >> 6, lane = tid & 63;
    const size_t gtid = (size_t)blockIdx.x * 512 + tid, gstride = (size_t)gridDim.x * 512;
    unsigned char* ws = P.ws;
    (void)gtid; (void)gstride;
    float* red = (float*)smem; float* ada = (float*)(ws + OFF_ADA);
    for (int task = blockIdx.x; task < 96; task += gridDim.x) {
        const int col = task * 64 + lane; float a0 = 0.f, a1 = 0.f, a2 = 0.f, a3 = 0.f;
        for (int kk = 0; kk < 128; ++kk) { const int k = wid * 128 + kk; const float wv = P.w_ada[(size_t)k * 6144 + col];
            const float c0 = P.c[k], c1 = P.c[1024 + k], c2 = P.c[2048 + k], c3 = P.c[3072 + k];
            a0 += c0 * sigmoidf_(c0) * wv; a1 += c1 * sigmoidf_(c1) * wv; a2 += c2 * sigmoidf_(c2) * wv; a3 += c3 * sigmoidf_(c3) * wv; }
        red[(wid * 4 + 0) * 64 + lane] = a0; red[(wid * 4 + 1) * 64 + lane] = a1; red[(wid * 4 + 2) * 64 + lane] = a2; red[(wid * 4 + 3) * 64 + lane] = a3;
        __syncthreads();
        if (tid < 256) { const int b = tid >> 6, l = tid & 63; float s = P.b_ada[task * 64 + l];
            for (int w = 0; w < 8; ++w) s += red[(w * 4 + b) * 64 + l];
            ada[b * 6144 + task * 64 + l] = s; }
        __syncthreads();
    }
}

__device__ void phase0_weights(const Params& P) {
    const size_t gtid = (size_t)blockIdx.x * 512 + threadIdx.x, gstride = (size_t)gridDim.x * 512;
    unsigned char* ws = P.ws;
    transpose_bf16<1>(P.w_in, 1024, 5408, (bf16_t*)(ws + OFF_WIN), 5632, gtid, gstride);
    transpose_bf16<0>(P.w_branch + 512 * 1024, 512, 1024, (bf16_t*)(ws + OFF_WBR) + 1024 * 512, 1024, gtid, gstride);
    transpose_bf16<0>(P.w2_decay, 64, 512, (bf16_t*)(ws + OFF_LORA), 512, gtid, gstride);
    transpose_bf16<0>(P.a2_iclr, 64, 512, (bf16_t*)(ws + OFF_LORA) + 512 * 64, 512, gtid, gstride);
    transpose_bf16<0>(P.g2_gate, 160, 512, (bf16_t*)(ws + OFF_LORA) + 2 * 512 * 64, 512, gtid, gstride);
}
__device__ void phase0_weights_late(const Params& P, unsigned char* smem, int bid, int nb) {
    const int tid = threadIdx.x;
    const size_t gtid = (size_t)bid * 512 + tid, gstride = (size_t)nb * 512;
    unsigned char* ws = P.ws;
    transpose_bf16<0>(P.w_branch, 512, 1024, (bf16_t*)(ws + OFF_WBR), 1024, gtid, gstride);
    transpose_bf16<0>(P.w_out, 1024, 1024, (bf16_t*)(ws + OFF_WOUT), 1024, gtid, gstride);
    float* WqS = (float*)smem; float* KgT = (float*)(smem + 32768); bf16_t* WcT = (bf16_t*)(ws + OFF_WC);
    for (int task = bid; task < 256; task += nb) {
        const int g = task >> 4, kt = task & 15, h = g >> 1, half = g & 1;
#pragma unroll
        for (int i = 0; i < 4; ++i) { const int idx = tid + i * 512, r = idx >> 5, d4 = idx & 31;
            *(f32x4*)(WqS + r * 128 + d4 * 4) = *(const f32x4*)(P.w_peer_q + (size_t)(kt * 64 + r) * 2048 + h * 256 + half * 128 + d4 * 4); }
#pragma unroll
        for (int i = 0; i < 8; ++i) { const int idx = tid + i * 512, key = idx >> 5, d4 = idx & 31;
            const f32x4 v = *(const f32x4*)(P.sub_keys + ((size_t)((half * 8 + h) * 128 + key)) * 128 + d4 * 4);
            KgT[(d4 * 4 + 0) * 129 + key] = v[0]; KgT[(d4 * 4 + 1) * 129 + key] = v[1]; KgT[(d4 * 4 + 2) * 129 + key] = v[2]; KgT[(d4 * 4 + 3) * 129 + key] = v[3]; }
        __syncthreads();
        const int key = tid & 127, kq = tid >> 7; float acc[16];
#pragma unroll
        for (int i = 0; i < 16; ++i) acc[i] = 0.f;
        for (int d4 = 0; d4 < 32; ++d4) {
            const float k0 = KgT[(d4 * 4 + 0) * 129 + key], k1 = KgT[(d4 * 4 + 1) * 129 + key], k2 = KgT[(d4 * 4 + 2) * 129 + key], k3 = KgT[(d4 * 4 + 3) * 129 + key];
#pragma unroll
            for (int i = 0; i < 16; ++i) { const f32x4 w4 = *(const f32x4*)(WqS + (kq * 16 + i) * 128 + d4 * 4); acc[i] += w4[0] * k0 + w4[1] * k1 + w4[2] * k2 + w4[3] * k3; }
        }
        bf16_t* dst = WcT + (size_t)(g * 128 + key) * 1024 + kt * 64 + kq * 16;
        u32x4 o0, o1; o0.x = cvt_pk_bf16(acc[0], acc[1]); o0.y = cvt_pk_bf16(acc[2], acc[3]); o0.z = cvt_pk_bf16(acc[4], acc[5]); o0.w = cvt_pk_bf16(acc[6], acc[7]);
        o1.x = cvt_pk_bf16(acc[8], acc[9]); o1.y = cvt_pk_bf16(acc[10], acc[11]); o1.z = cvt_pk_bf16(acc[12], acc[13]); o1.w = cvt_pk_bf16(acc[14], acc[15]);
        *(u32x4*)dst = o0; *(u32x4*)(dst + 8) = o1;
        __syncthreads();
    }
}

__device__ void phase_norm(const float* __restrict__ X, const float* __restrict__ gain, const float* __restrict__ ada, int shift_off, int scale_off, bf16_t* __restrict__ H) {
    const int lane = threadIdx.x & 63, gw = blockIdx.x * 8 + (threadIdx.x >> 6), nw = gridDim.x * 8;
    for (int row = gw; row < NTOK; row += nw) {
        const int b = row / SEQL; const float* xr = X + (size_t)row * DM; f32x4 v[4]; float ss = 0.f;
#pragma unroll
        for (int i = 0; i < 4; ++i) { v[i] = *(const f32x4*)(xr + (i >> 1) * 512 + lane * 8 + (i & 1) * 4); ss += v[i][0] * v[i][0] + v[i][1] * v[i][1] + v[i][2] * v[i][2] + v[i][3] * v[i][3]; }
        ss += __shfl_xor(ss, 1); ss += __shfl_xor(ss, 2); ss += __shfl_xor(ss, 4); ss += __shfl_xor(ss, 8); ss += __shfl_xor(ss, 16); ss += __shfl_xor(ss, 32);
        const float rinv = rsqrtf(ss * (1.0f / 1024.0f) + 1e-6f);
#pragma unroll
        for (int ih = 0; ih < 2; ++ih) { u32x4 o;
#pragma unroll
            for (int q = 0; q < 2; ++q) { const int c = ih * 512 + lane * 8 + q * 4; const f32x4 g = *(const f32x4*)(gain + c), sh = *(const f32x4*)(ada + b * 6144 + shift_off + c), sc = *(const f32x4*)(ada + b * 6144 + scale_off + c);
                const f32x4 h = v[ih * 2 + q] * rinv * g * (sc + 1.0f) + sh;
                if (q == 0) { o.x = cvt_pk_bf16(h[0], h[1]); o.y = cvt_pk_bf16(h[2], h[3]); } else { o.z = cvt_pk_bf16(h[0], h[1]); o.w = cvt_pk_bf16(h[2], h[3]); } }
            *(u32x4*)(H + (size_t)row * DM + ih * 512 + lane * 8) = o; }
    }
}

struct ScanBufs { bf16_t *sr, *sw, *sk, *sv, *skk, *sb, *g1, *g2; };
__device__ __forceinline__ float lerp_bf(unsigned short p, unsigned short pp, float mu) { const float a = __uint_as_float((unsigned)p << 16), b = __uint_as_float((unsigned)pp << 16); return a + (b - a) * mu; }
__device__ __forceinline__ unsigned prev_dw(unsigned x, unsigned first) { return (unsigned)__builtin_amdgcn_update_dpp((int)first, (int)x, 0x111, 0xF, 0xF, false); }
__device__ __forceinline__ u32x2 prev_v2(const u32x2 x, const u32x2 first) { u32x2 r; r.x = prev_dw(x.x, first.x); r.y = prev_dw(x.y, first.y); return r; }
__device__ void phase_rwkv_prep(const Params& P, const ScanBufs& S, unsigned char* smem) {
    const int lane = threadIdx.x & 63, gw = blockIdx.x * 8 + (threadIdx.x >> 6), nw = gridDim.x * 8, fr = lane & 15, fq = lane >> 4;
    const bf16_t* projR = (const bf16_t*)(P.ws + OFF_PR); const bf16_t* w2t = (const bf16_t*)(P.ws + OFF_LORA); const bf16_t* a2t = w2t + 512 * 64; const bf16_t* g2t = w2t + 2 * 512 * 64;
#pragma unroll 1
    for (int tt = gw; tt < NTOK / 16; tt += nw) {
        const int t = tt * 16 + fr, b = t / SEQL, s = t - b * SEQL; const bool hp0 = (fr == 0) && (s != 0);
        const bf16_t* prow = projR + (size_t)t * 2048; const bf16_t* pprev = prow - 2048;
        unsigned char* tokS = smem + (threadIdx.x >> 6) * 9216 + lane * 16;
#pragma unroll
        for (int kb = 0; kb < 9; ++kb) { const int c = 1536 + kb * 32 + fq * 8; const u32x4 pv = *(const u32x4*)(prow + c); u32x4 q0 = {0u, 0u, 0u, 0u}; if (hp0) q0 = *(const u32x4*)(pprev + c);
            u32x4 qv; qv.x = prev_dw(pv.x, q0.x); qv.y = prev_dw(pv.y, q0.y); qv.z = prev_dw(pv.z, q0.z); qv.w = prev_dw(pv.w, q0.w);
            float a[8], q[8]; unpack8(pv, a); unpack8(qv, q); const f32x4 m0 = *(const f32x4*)(P.mu + c), m1 = *(const f32x4*)(P.mu + c + 4);
#pragma unroll
            for (int j = 0; j < 8; ++j) { const float mu = j < 4 ? m0[j] : m1[j - 4]; float xm = a[j] + (q[j] - a[j]) * mu;
                if (kb < 2) xm = 1.0f - 2.0f * __builtin_amdgcn_rcpf(__expf(2.0f * xm) + 1.0f); else if (kb >= 4) xm = sigmoidf_(xm);
                a[j] = xm; }
            const u32x4 pk = pack8(a); *(u32x4*)(tokS + kb * 1024) = pk; }
        u32x2 cr[4], ck[4], cv[4];
#pragma unroll
        for (int n = 0; n < 4; ++n) { const int c0 = n * 16 + fq * 4; cr[n] = *(const u32x2*)(prow + c0); ck[n] = *(const u32x2*)(prow + 512 + c0); cv[n] = *(const u32x2*)(prow + 1024 + c0); }
#pragma unroll 1
        for (int h = 0; h < 8; ++h) {
            u32x2 nr[4], nk[4], nv[4];
#pragma unroll
            for (int n = 0; n < 4; ++n) { const int c0 = (h < 7 ? h + 1 : 7) * 64 + n * 16 + fq * 4; nr[n] = *(const u32x2*)(prow + c0); nk[n] = *(const u32x2*)(prow + 512 + c0); nv[n] = *(const u32x2*)(prow + 1024 + c0); }
            f32x4 accw[4], acca[4], accg[4];
#pragma unroll
            for (int n = 0; n < 4; ++n) { const int oc = h * 64 + n * 16 + fr; accw[n] = (f32x4){0.f, 0.f, 0.f, 0.f}; acca[n] = accw[n]; accg[n] = accw[n];
#pragma unroll
                for (int kb = 0; kb < 2; ++kb) { const bf16x8 wf = *(const bf16x8*)(w2t + oc * 64 + kb * 32 + fq * 8); accw[n] = __builtin_amdgcn_mfma_f32_16x16x32_bf16(wf, *(const bf16x8*)(tokS + kb * 1024), accw[n], 0, 0, 0); }
#pragma unroll
                for (int kb = 0; kb < 2; ++kb) { const bf16x8 wf = *(const bf16x8*)(a2t + oc * 64 + kb * 32 + fq * 8); acca[n] = __builtin_amdgcn_mfma_f32_16x16x32_bf16(wf, *(const bf16x8*)(tokS + (2 + kb) * 1024), acca[n], 0, 0, 0); }
#pragma unroll
                for (int kb = 0; kb < 5; ++kb) { const bf16x8 wf = *(const bf16x8*)(g2t + oc * 160 + kb * 32 + fq * 8); accg[n] = __builtin_amdgcn_mfma_f32_16x16x32_bf16(wf, *(const bf16x8*)(tokS + (4 + kb) * 1024), accg[n], 0, 0, 0); }
                 }
            const size_t obase = ((size_t)(b * 8 + h) * SEQL + s) * 64;
            float ss = 0.f, bon = 0.f;
#pragma unroll
            for (int n = 0; n < 4; ++n) { const int c0 = h * 64 + n * 16 + fq * 4;
                const u32x2 k2 = ck[n]; u32x2 kp0 = {0u, 0u}; if (hp0) kp0 = *(const u32x2*)(pprev + 512 + c0); const u32x2 kp = prev_v2(k2, kp0);
                const f32x4 muk = *(const f32x4*)(P.mu + 512 + c0), kkp = *(const f32x4*)(P.k_k + c0);
                const float k0 = bflo(k2.x), k1 = bfhi(k2.x), k2_ = bflo(k2.y), k3 = bfhi(k2.y), q0 = bflo(kp.x), q1 = bfhi(kp.x), q2 = bflo(kp.y), q3 = bfhi(kp.y);
                const float e0 = (k0 + (q0 - k0) * muk[0]) * kkp[0], e1 = (k1 + (q1 - k1) * muk[1]) * kkp[1], e2 = (k2_ + (q2 - k2_) * muk[2]) * kkp[2], e3 = (k3 + (q3 - k3) * muk[3]) * kkp[3];
                ss += e0 * e0 + e1 * e1 + e2 * e2 + e3 * e3; }
            ss += __shfl_xor(ss, 16); ss += __shfl_xor(ss, 32);
            const float inv = 1.0f / fmaxf(sqrtf(ss), 1e-12f);

#pragma unroll
            for (int n = 0; n < 4; ++n) { const int c0 = h * 64 + n * 16 + fq * 4;
                const u32x2 r2 = cr[n], k2 = ck[n];
                u32x2 rp0 = {0u, 0u}, kp0 = {0u, 0u}; if (hp0) { rp0 = *(const u32x2*)(pprev + c0); kp0 = *(const u32x2*)(pprev + 512 + c0); } const u32x2 rp = prev_v2(r2, rp0), kp = prev_v2(k2, kp0);
                const f32x4 mur = *(const f32x4*)(P.mu + c0), muk = *(const f32x4*)(P.mu + 512 + c0);
                const f32x4 w0v = *(const f32x4*)(P.w0 + c0), a0v = *(const f32x4*)(P.a0 + c0), kkp = *(const f32x4*)(P.k_k + c0), kap = *(const f32x4*)(P.k_a + c0), rkp = *(const f32x4*)(P.r_k + c0), lw = *(const f32x4*)(P.lnx_w + c0);
                float rr[4], kn[4], om[4], kk[4], bb[4], g1[4];
#pragma unroll
                for (int j = 0; j < 4; ++j) {
                    const unsigned rw = j < 2 ? r2.x : r2.y, rpw = j < 2 ? rp.x : rp.y, kw = j < 2 ? k2.x : k2.y, kpw = j < 2 ? kp.x : kp.y;
                    const float r_ = (j & 1) ? bfhi(rw) : bflo(rw), rp_ = (j & 1) ? bfhi(rpw) : bflo(rpw), k_ = (j & 1) ? bfhi(kw) : bflo(kw), kp_ = (j & 1) ? bfhi(kpw) : bflo(kpw);
                    const float r = r_ + (rp_ - r_) * mur[j], k = k_ + (kp_ - k_) * muk[j];
                    const float wl = w0v[j] + accw[n][j]; const float z = -wl; const float sp = fmaxf(z, 0.f) + __logf(1.0f + __expf(-fabsf(z)));
                    const float e = __expf(-sp - 0.5f); om[j] = 1.0f - __expf(-e);
                    const float a = sigmoidf_(a0v[j] + acca[n][j]);
                    kk[j] = k * kkp[j] * inv; bb[j] = kk[j] * a;
                    kn[j] = k * (1.0f + (a - 1.0f) * kap[j]); rr[j] = r; bon += r * kn[j] * rkp[j]; g1[j] = lw[j] * accg[n][j];
                }
                u32x2 o; o.x = cvt_pk_bf16(rr[0], rr[1]); o.y = cvt_pk_bf16(rr[2], rr[3]); *(u32x2*)(S.sr + obase + n * 16 + fq * 4) = o;
                o.x = cvt_pk_bf16(om[0], om[1]); o.y = cvt_pk_bf16(om[2], om[3]); *(u32x2*)(S.sw + obase + n * 16 + fq * 4) = o;
                o.x = cvt_pk_bf16(kn[0], kn[1]); o.y = cvt_pk_bf16(kn[2], kn[3]); *(u32x2*)(S.sk + obase + n * 16 + fq * 4) = o;
                o.x = cvt_pk_bf16(kk[0], kk[1]); o.y = cvt_pk_bf16(kk[2], kk[3]); *(u32x2*)(S.skk + obase + n * 16 + fq * 4) = o;
                o.x = cvt_pk_bf16(bb[0], bb[1]); o.y = cvt_pk_bf16(bb[2], bb[3]); *(u32x2*)(S.sb + obase + n * 16 + fq * 4) = o;
                o.x = cvt_pk_bf16(g1[0], g1[1]); o.y = cvt_pk_bf16(g1[2], g1[3]); *(u32x2*)(S.g1 + obase + n * 16 + fq * 4) = o;

            }
            bon += __shfl_xor(bon, 16); bon += __shfl_xor(bon, 32);
#pragma unroll
            for (int n = 0; n < 4; ++n) { const int c0 = h * 64 + n * 16 + fq * 4;
                const u32x2 v2 = cv[n]; u32x2 vp0 = {0u, 0u}; if (hp0) vp0 = *(const u32x2*)(pprev + 1024 + c0); const u32x2 vp = prev_v2(v2, vp0);
                const f32x4 muv = *(const f32x4*)(P.mu + 1024 + c0), lb = *(const f32x4*)(P.lnx_b + c0);
                const float v0 = bflo(v2.x), v1 = bfhi(v2.x), v2_ = bflo(v2.y), v3 = bfhi(v2.y), q0 = bflo(vp.x), q1 = bfhi(vp.x), q2 = bflo(vp.y), q3 = bfhi(vp.y);
                float vv[4]; vv[0] = v0 + (q0 - v0) * muv[0]; vv[1] = v1 + (q1 - v1) * muv[1]; vv[2] = v2_ + (q2 - v2_) * muv[2]; vv[3] = v3 + (q3 - v3) * muv[3];
                float g2[4];
#pragma unroll
                for (int j = 0; j < 4; ++j) g2[j] = (lb[j] + bon * vv[j]) * accg[n][j];
                u32x2 o; o.x = cvt_pk_bf16(vv[0], vv[1]); o.y = cvt_pk_bf16(vv[2], vv[3]); *(u32x2*)(S.sv + obase + n * 16 + fq * 4) = o;
                o.x = cvt_pk_bf16(g2[0], g2[1]); o.y = cvt_pk_bf16(g2[2], g2[3]); *(u32x2*)(S.g2 + obase + n * 16 + fq * 4) = o;
            }

#pragma unroll
            for (int n = 0; n < 4; ++n) { cr[n] = nr[n]; ck[n] = nk[n]; cv[n] = nv[n]; }
        }
    }
}

__device__ void phase_moba_prep(const Params& P, unsigned char* smem) {
    const int tid = threadIdx.x; bf16_t* projM = (bf16_t*)(P.ws + OFF_PM); float* kmean = (float*)(P.ws + OFF_KMEAN);
    float* kred = (float*)smem;
    float* part = (float*)(smem + 66560);
    bf16_t* Vs = (bf16_t*)(smem + 66560 + 2048);
    for (int task = blockIdx.x; task < 1024; task += gridDim.x) {
        const int h = task & 7, blk = (task >> 3) & 31, b = task >> 8; const size_t tok0 = (size_t)b * SEQL + blk * 256;
#pragma unroll 2
        for (int ps = 0; ps < 8; ++ps) { const int rowid = ps * 64 + (tid >> 3), part_ = rowid >> 8, token = rowid & 255, seg = tid & 7;
            bf16_t* ptr = projM + (tok0 + token) * 1536 + part_ * 512 + h * 64 + seg * 8; const float* gn = (part_ ? P.k_norm_g : P.q_norm_g) + seg * 8;
            const u32x4 v = *(const u32x4*)ptr; float f[8]; unpack8(v, f); float ss = 0.f;
#pragma unroll
            for (int j = 0; j < 8; ++j) ss += f[j] * f[j];
            ss += dppf0<0xB1>(ss); ss += dppf0<0x4E>(ss); ss += dppf0<0x141>(ss);
            const float rinv = rsqrtf(ss * (1.0f / 64.0f) + 1e-6f) * (part_ ? 1.0f : 0.125f * 1.4426950408889634f);
            const f32x4 g0 = *(const f32x4*)gn, g1 = *(const f32x4*)(gn + 4);
#pragma unroll
            for (int j = 0; j < 8; ++j) { f[j] = f[j] * rinv * (j < 4 ? g0[j] : g1[j - 4]); if (part_) kred[token * 65 + seg * 8 + j] = f[j]; }
            *(u32x4*)ptr = pack8(f); }
#pragma unroll
        for (int i = 0; i < 4; ++i) { const int c = tid + i * 512, key = c >> 3, d8 = c & 7; const u32x4 v = *(const u32x4*)(projM + (tok0 + key) * 1536 + 1024 + h * 64 + d8 * 8);
            unsigned short* d = (unsigned short*)(Vs + key * 65 + d8 * 8);
            d[0] = (unsigned short)(v.x & 0xffff); d[1] = (unsigned short)(v.x >> 16); d[2] = (unsigned short)(v.y & 0xffff); d[3] = (unsigned short)(v.y >> 16);
            d[4] = (unsigned short)(v.z & 0xffff); d[5] = (unsigned short)(v.z >> 16); d[6] = (unsigned short)(v.w & 0xffff); d[7] = (unsigned short)(v.w >> 16); }
        __syncthreads();
        { const int d = tid & 63, seg = tid >> 6; float s = 0.f; for (int i = 0; i < 32; ++i) s += kred[(seg * 32 + i) * 65 + d]; part[seg * 64 + d] = s; }
#pragma unroll
        for (int i = 0; i < 4; ++i) { const int c = tid + i * 512, d = c >> 5, key8 = c & 31; unsigned short e[8];
#pragma unroll
            for (int j = 0; j < 8; ++j) e[j] = Vs[(key8 * 8 + j) * 65 + d];
            u32x4 o; o.x = e[0] | ((unsigned)e[1] << 16); o.y = e[2] | ((unsigned)e[3] << 16); o.z = e[4] | ((unsigned)e[5] << 16); o.w = e[6] | ((unsigned)e[7] << 16);
            *(u32x4*)(projM + (tok0 + d * 4 + (key8 >> 3)) * 1536 + 1024 + h * 64 + (key8 & 7) * 8) = o; }
        __syncthreads();
        if (tid < 64) { float s = 0.f; for (int w = 0; w < 8; ++w) s += part[w * 64 + tid]; kmean[((size_t)((b * 8 + h) * 32 + blk)) * 64 + tid] = s * (1.0f / 256.0f); }
        __syncthreads();
    }
}

__device__ void phase_scan(const Params& P, const ScanBufs& S, float* __restrict__ Oraw, unsigned char* smem, int sb, int nsb, unsigned* prog) {
    const int tid = threadIdx.x, wid = tid >> 6, lane = tid & 63, g = lane >> 4, li = lane & 15;
    constexpr int BUFB = 5 * 8192 + 2048;
    for (int task = sb; task < 128; task += nsb) {
        const int seq = task >> 2, rowbase = (task & 3) * 16; const size_t sbase = (size_t)seq * SEQL * 64;
        const bf16_t* arr[5] = {S.skk, S.sw, S.sk, S.sb, S.sr};
        u32x4 ldA[5], ldB[5]; u32x4 ldvA = {0u, 0u, 0u, 0u}, ldvB = ldvA; const int stid = tid - 256;
        auto gload = [&](int c, u32x4 (&ld)[5], u32x4& ldv) {
            if (stid >= 0) {
#pragma unroll
                for (int a = 0; a < 5; ++a) ld[a] = *(const u32x4*)(arr[a] + sbase + (size_t)c * 2048 + stid * 8);
                if (stid < 64) ldv = *(const u32x4*)(S.sv + sbase + (size_t)(c * 32 + (stid >> 1)) * 64 + rowbase + (stid & 1) * 8); }
        };
        auto lstore = [&](int bufi, const u32x4 (&ld)[5], const u32x4& ldv) { unsigned char* bb = smem + bufi * BUFB;
            if (stid >= 0) {
#pragma unroll
                for (int a = 0; a < 5; ++a) { float f[8]; unpack8(ld[a], f);
                    if (a == 1) {
#pragma unroll
                        for (int j = 0; j < 8; ++j) f[j] = 1.0f - f[j]; }
                    *(f32x4*)(bb + a * 8192 + stid * 32) = (f32x4){f[0], f[1], f[2], f[3]}; *(f32x4*)(bb + a * 8192 + stid * 32 + 16) = (f32x4){f[4], f[5], f[6], f[7]}; }
                if (stid < 64) { float f[8]; unpack8(ldv, f); *(f32x4*)(bb + 5 * 8192 + stid * 32) = (f32x4){f[0], f[1], f[2], f[3]}; *(f32x4*)(bb + 5 * 8192 + stid * 32 + 16) = (f32x4){f[4], f[5], f[6], f[7]}; } }
        };
        f32x2 sA = {0.f, 0.f}, sB = {0.f, 0.f};
        const int row = rowbase + wid * 4 + g;
#define SC_LO(v) __builtin_shufflevector(v, v, 0, 1)
#define SC_HI(v) __builtin_shufflevector(v, v, 2, 3)
        auto compute = [&](int c) {
            if (wid < 4) {
                const unsigned char* bb = smem + (c & 1) * BUFB;
                float p;
                { const f32x4 kk = *(const f32x4*)(bb + li * 16); const f32x2 t = sA * SC_LO(kk) + sB * SC_HI(kk); p = row_sum16(t.x + t.y); }
                for (int hf = 0; hf < 2; ++hf) {
                    float qp[16];
#pragma unroll
                    for (int s16 = 0; s16 < 16; ++s16) { const int st = hf * 16 + s16;
                        const f32x4 w = *(const f32x4*)(bb + 1 * 8192 + st * 256 + li * 16), k = *(const f32x4*)(bb + 2 * 8192 + st * 256 + li * 16),
                                    bv = *(const f32x4*)(bb + 3 * 8192 + st * 256 + li * 16), r = *(const f32x4*)(bb + 4 * 8192 + st * 256 + li * 16),
                                    kn = *(const f32x4*)(bb + 0 * 8192 + (st + 1) * 256 + li * 16);
                        const float vv = *(const float*)(bb + 5 * 8192 + st * 64 + (wid * 4 + g) * 4);
                        const f32x2 pv = {p, p}, vv2 = {vv, vv};
                        sA = sA * SC_LO(w) + (SC_LO(k) * vv2 - SC_LO(bv) * pv); sB = sB * SC_HI(w) + (SC_HI(k) * vv2 - SC_HI(bv) * pv);
                        const f32x2 qq = sA * SC_LO(r) + sB * SC_HI(r), pp = sA * SC_LO(kn) + sB * SC_HI(kn);
                        qp[s16] = qq.x + qq.y; float pn = pp.x + pp.y;
                        pn += dppf0<0xB1>(pn); pn += dppf0<0x4E>(pn); pn += dppf0<0x141>(pn); pn += dppf0<0x140>(pn);
                        p = pn;
                        if ((s16 & 3) == 3) asm volatile("" ::: "memory");
                    }
                    float q8[8], q4[4], q2[2], qo;
                    { const bool hi = (li & 8) != 0;
#pragma unroll
                      for (int j = 0; j < 8; ++j) { const float send = hi ? qp[j] : qp[j + 8], keep = hi ? qp[j + 8] : qp[j]; q8[j] = keep + dppf0<0x140>(send); } }
                    { const bool hi = (li & 4) != 0;
#pragma unroll
                      for (int j = 0; j < 4; ++j) { const float send = hi ? q8[j] : q8[j + 4], keep = hi ? q8[j + 4] : q8[j]; q4[j] = keep + dppf0<0x141>(send); } }
                    { const bool hi = (li & 2) != 0;
#pragma unroll
                      for (int j = 0; j < 2; ++j) { const float send = hi ? q4[j] : q4[j + 2], keep = hi ? q4[j + 2] : q4[j]; q2[j] = keep + dppf0<0x1B>(send); } }
                    { const bool hi = (li & 1) != 0; const float send = hi ? q2[0] : q2[1], keep = hi ? q2[1] : q2[0]; qo = keep + dppf0<0xB1>(send); }
                    Oraw[((size_t)seq * 64 + row) * SEQL + c * 32 + hf * 16 + li] = qo;
                }
            }
        };
        gload(0, ldA, ldvA); lstore(0, ldA, ldvA); gload(1, ldB, ldvB); __syncthreads();
        for (int c = 0; c < 256; c += 2) {
            if (c + 2 < 256) gload(c + 2, ldA, ldvA);
            compute(c);
            lstore(1, ldB, ldvB);
            __syncthreads();
            if (c + 3 < 256) gload(c + 3, ldB, ldvB);
            compute(c + 1);
            if (c + 2 < 256) lstore(0, ldA, ldvA);
            __syncthreads();
            if (((c + 1) & 31) == 31 && tid == 0) { __builtin_amdgcn_fence(__ATOMIC_RELEASE, "agent"); __hip_atomic_fetch_add(prog + task * 16, 1u, __ATOMIC_RELAXED, __HIP_MEMORY_SCOPE_AGENT); }
        }
    }
}

__device__ void phase_moba(const Params& P, bf16_t* __restrict__ yb, unsigned char* smem, unsigned* queue, unsigned* udone) {
    const int tid = threadIdx.x, wid = tid >> 6, lane = tid & 63, g = lane >> 4, m = lane & 15;
    const bf16_t* projM = (const bf16_t*)(P.ws + OFF_PM); const float* kmean = (const float*)(P.ws + OFF_KMEAN);
    unsigned char* Ks = smem; unsigned char* Vts = smem + 36864; float* acc = (float*)(smem + 70656); float* kmS = (float*)(smem + 140288);
    int* cnt = (int*)(smem + 148480); int* offs = cnt + 32; unsigned short* list = (unsigned short*)(smem + 148800);
    int* qslot = (int*)(smem + 150336);
    int qx = (int)(blockIdx.x & 7), tries = 0;
    bool didone = false;
    for (;;) {
        __syncthreads();
        if (tid == 0) { if (didone) { __builtin_amdgcn_fence(__ATOMIC_RELEASE, "agent"); __hip_atomic_fetch_add(udone, 1u, __ATOMIC_RELAXED, __HIP_MEMORY_SCOPE_AGENT); }
            int n = -1, x = qx, tr = tries;
            while (tr < 8) { n = (int)atomicAdd(queue + x * 16, 1u); if (n < 128) break; n = -1; x = (x + 1) & 7; ++tr; }
            qslot[0] = n; qslot[1] = x; qslot[2] = tr; }
        __syncthreads();
        const int n = qslot[0]; qx = qslot[1]; tries = qslot[2]; if (n < 0) break;
        didone = true;
        const int bh = qx + 8 * (n >> 5), i = 31 - (n & 31);
        const int b = bh >> 3, h = bh & 7; const size_t tokb = (size_t)b * SEQL, tok0 = tokb + (size_t)i * 256;
        for (int e = tid; e < 256 * 68; e += 512) acc[e] = 0.f;
        for (int e = tid; e < i * 64; e += 512) kmS[e] = kmean[(size_t)(bh * 32) * 64 + e];
        if (tid < 32) cnt[tid] = 0;
        __syncthreads();
        int selj[3] = {-1, -1, -1}, slot[3] = {0, 0, 0}; const int nsel = i < 3 ? i : 3;
        if (tid < 256 && i > 0) {
            float q[64]; const bf16_t* qp = projM + (tok0 + tid) * 1536 + h * 64;
#pragma unroll
            for (int t8 = 0; t8 < 8; ++t8) { const u32x4 v = *(const u32x4*)(qp + t8 * 8); float f[8]; unpack8(v, f);
#pragma unroll
                for (int j = 0; j < 8; ++j) q[t8 * 8 + j] = f[j]; }
            float b0 = -3e38f, b1 = -3e38f, b2 = -3e38f; int j0 = -1, j1 = -1, j2 = -1;
            for (int j = 0; j < i; ++j) { float d = 0.f;
#pragma unroll
                for (int t4 = 0; t4 < 16; ++t4) { const f32x4 kv = *(const f32x4*)(kmS + j * 64 + t4 * 4); d += q[t4 * 4] * kv[0] + q[t4 * 4 + 1] * kv[1] + q[t4 * 4 + 2] * kv[2] + q[t4 * 4 + 3] * kv[3]; }
                if (d > b0) { b2 = b1; j2 = j1; b1 = b0; j1 = j0; b0 = d; j0 = j; } else if (d > b1) { b2 = b1; j2 = j1; b1 = d; j1 = j; } else if (d > b2) { b2 = d; j2 = j; } }
            selj[0] = j0; selj[1] = j1; selj[2] = j2;
#pragma unroll
            for (int s = 0; s < 3; ++s) if (s < nsel) slot[s] = atomicAdd(&cnt[selj[s]], 1);
        }
        __syncthreads();
        if (tid == 0) { int o = 0; for (int j = 0; j < 32; ++j) { offs[j] = o; o += cnt[j]; } offs[32] = o; }
        __syncthreads();
        if (tid < 256 && i > 0) {
#pragma unroll
            for (int s = 0; s < 3; ++s) if (s < nsel) list[offs[selj[s]] + slot[s]] = (unsigned short)tid;
        }
        __syncthreads();
        u32x4 kreg[4], vreg[4];
        auto tload = [&](int jt) { const size_t tokj = tokb + (size_t)jt * 256;
#pragma unroll
            for (int t4 = 0; t4 < 4; ++t4) { const int c = tid + t4 * 512;
                { const int key = c >> 3, d8 = c & 7; kreg[t4] = *(const u32x4*)(projM + (tokj + key) * 1536 + 512 + h * 64 + d8 * 8); }
                { const int d = c >> 5, key8 = c & 31; vreg[t4] = *(const u32x4*)(projM + (tokj + d * 4 + (key8 >> 3)) * 1536 + 1024 + h * 64 + (key8 & 7) * 8); } } };
        auto nexttile = [&](int from) { int jt = from; while (jt < i && cnt[jt] == 0) ++jt; return jt; };
        int jn = nexttile(0);
        tload(jn);
        while (jn <= i) {
            const int j = jn; const bool own = (j == i); const int nq = own ? 256 : cnt[j];
            const int ng = (nq + 15) >> 4, lbase = own ? 0 : offs[j];
            int qpos = wid * 16 + m; bool valid = qpos < nq; int qi = own ? qpos : (int)list[lbase + (valid ? qpos : 0)];
            bf16x8 qf0, qf1;
            { const bf16_t* qp = projM + (tok0 + qi) * 1536 + h * 64 + g * 8; qf0 = *(const bf16x8*)qp; qf1 = *(const bf16x8*)(qp + 32); }
            __syncthreads();
#pragma unroll
            for (int t4 = 0; t4 < 4; ++t4) { const int c = tid + t4 * 512;
                { const int key = c >> 3, d8 = c & 7; *(u32x4*)(Ks + key * 144 + d8 * 16) = kreg[t4]; }
                { const int d = c >> 5, key8 = c & 31; *(u32x4*)(Vts + d * 528 + key8 * 16) = vreg[t4]; } }
            __syncthreads();
            jn = own ? i + 1 : nexttile(j + 1);
            if (jn <= i) tload(jn);
            for (int grp = wid; grp < ng; grp += 8) {
                if (grp != wid) { qpos = grp * 16 + m; valid = qpos < nq; qi = own ? qpos : (int)list[lbase + (valid ? qpos : 0)];
                    const bf16_t* qp = projM + (tok0 + qi) * 1536 + h * 64 + g * 8; qf0 = *(const bf16x8*)qp; qf1 = *(const bf16x8*)(qp + 32); }
                const int nslab = own ? (grp >> 1) + 1 : 8;
                f32x4 o[4]; float dsum = 0.f;
#pragma unroll
                for (int dt = 0; dt < 4; ++dt) o[dt] = (f32x4){0.f, 0.f, 0.f, 0.f};
                const unsigned char* kbase = Ks + (8 * (m >> 2) + (m & 3)) * 144 + g * 16; const unsigned char* vbase = Vts + m * 528 + g * 16;
                bf16x8 kf0 = *(const bf16x8*)(kbase), kf1 = *(const bf16x8*)(kbase + 64), kf2 = *(const bf16x8*)(kbase + 4 * 144), kf3 = *(const bf16x8*)(kbase + 4 * 144 + 64);
                for (int sl = 0; sl < nslab; ++sl) {
                    const bf16x8 vf0 = *(const bf16x8*)(vbase + sl * 64), vf1 = *(const bf16x8*)(vbase + 16 * 528 + sl * 64), vf2 = *(const bf16x8*)(vbase + 32 * 528 + sl * 64), vf3 = *(const bf16x8*)(vbase + 48 * 528 + sl * 64);
                    __builtin_amdgcn_sched_barrier(0);
                    f32x4 s0 = (f32x4){0.f, 0.f, 0.f, 0.f}, s1 = s0;
                    s0 = __builtin_amdgcn_mfma_f32_16x16x32_bf16(kf0, qf0, s0, 0, 0, 0);
                    s0 = __builtin_amdgcn_mfma_f32_16x16x32_bf16(kf1, qf1, s0, 0, 0, 0);
                    s1 = __builtin_amdgcn_mfma_f32_16x16x32_bf16(kf2, qf0, s1, 0, 0, 0);
                    s1 = __builtin_amdgcn_mfma_f32_16x16x32_bf16(kf3, qf1, s1, 0, 0, 0);
                    { const unsigned char* kn = kbase + (sl + 1 < nslab ? sl + 1 : sl) * 32 * 144;
                      kf0 = *(const bf16x8*)(kn); kf1 = *(const bf16x8*)(kn + 64); kf2 = *(const bf16x8*)(kn + 4 * 144); kf3 = *(const bf16x8*)(kn + 4 * 144 + 64); }
                    __builtin_amdgcn_sched_barrier(0);
                    float p[8];
#pragma unroll
                    for (int jj = 0; jj < 4; ++jj) { p[jj] = __builtin_amdgcn_exp2f(s0[jj]); p[4 + jj] = __builtin_amdgcn_exp2f(s1[jj]); }
                    if (own && sl == nslab - 1) {
#pragma unroll
                        for (int jj = 0; jj < 8; ++jj) if (sl * 32 + 8 * g + jj > qpos) p[jj] = 0.f; }
#pragma unroll
                    for (int jj = 0; jj < 8; ++jj) dsum += p[jj];
                    const u32x4 pk = pack8(p); const bf16x8 pb = __builtin_bit_cast(bf16x8, pk);
                    o[0] = __builtin_amdgcn_mfma_f32_16x16x32_bf16(vf0, pb, o[0], 0, 0, 0); o[1] = __builtin_amdgcn_mfma_f32_16x16x32_bf16(vf1, pb, o[1], 0, 0, 0);
                    o[2] = __builtin_amdgcn_mfma_f32_16x16x32_bf16(vf2, pb, o[2], 0, 0, 0); o[3] = __builtin_amdgcn_mfma_f32_16x16x32_bf16(vf3, pb, o[3], 0, 0, 0);
                }
                dsum += __shfl_xor(dsum, 16); dsum += __shfl_xor(dsum, 32);
                if (valid) {
#pragma unroll
                    for (int dt = 0; dt < 4; ++dt) { f32x4* ap = (f32x4*)(acc + qi * 68 + dt * 16 + 4 * g); *ap = *ap + o[dt]; }
                    if (g == 0) acc[qi * 68 + 64] += dsum;
                }
            }
        }
        __syncthreads();
        { const int q = tid >> 1, hf = tid & 1; const float inv = 1.0f / acc[q * 68 + 64]; bf16_t* dst = yb + (tok0 + q) * 512 + h * 64 + hf * 32;
#pragma unroll
          for (int t8 = 0; t8 < 4; ++t8) { float f[8];
#pragma unroll
              for (int j = 0; j < 8; ++j) f[j] = acc[q * 68 + hf * 32 + t8 * 8 + j] * inv;
              *(u32x4*)(dst + t8 * 8) = pack8(f); } }
        __syncthreads();
    }
}

__device__ void phase_gn(const ScanBufs& S, const float* __restrict__ Oraw, bf16_t* __restrict__ ya, int bid, int nblk, const unsigned* prog) {
    const int lane = threadIdx.x & 63, gw = bid * 8 + (threadIdx.x >> 6), nw = nblk * 8;
    for (int task = gw; task < 32 * 128; task += nw) {
        const int seq = task & 31, t64 = task >> 5, s = t64 * 64 + lane, b = seq >> 3, h = seq & 7;
        if (prog) { const unsigned need = (unsigned)((t64 >> 4) + 1);
#pragma unroll
            for (int q = 0; q < 4; ++q) while (__hip_atomic_load(prog + (seq * 4 + q) * 16, __ATOMIC_RELAXED, __HIP_MEMORY_SCOPE_AGENT) < need) __builtin_amdgcn_s_sleep(8);
            __builtin_amdgcn_fence(__ATOMIC_ACQUIRE, "agent"); }
        float o[64]; float mean = 0.f;
#pragma unroll
        for (int v = 0; v < 64; ++v) { o[v] = Oraw[((size_t)seq * 64 + v) * SEQL + s]; mean += o[v]; }
        mean *= (1.0f / 64.0f); float var = 0.f;
#pragma unroll
        for (int v = 0; v < 64; ++v) { const float d = o[v] - mean; var += d * d; }
        const float rstd = rsqrtf(var * (1.0f / 64.0f) + 64e-5f);
        const size_t gb = ((size_t)seq * SEQL + s) * 64; bf16_t* dst = ya + ((size_t)b * SEQL + s) * 512 + h * 64;
#pragma unroll
        for (int t8 = 0; t8 < 8; ++t8) { const u32x4 a = *(const u32x4*)(S.g1 + gb + t8 * 8), c = *(const u32x4*)(S.g2 + gb + t8 * 8); float fa[8], fc[8], f[8]; unpack8(a, fa); unpack8(c, fc);
#pragma unroll
            for (int j = 0; j < 8; ++j) f[j] = (o[t8 * 8 + j] - mean) * rstd * fa[j] + fc[j];
            *(u32x4*)(dst + t8 * 8) = pack8(f); }
    }
}

__device__ void convert_bf16(const float* __restrict__ src, bf16_t* __restrict__ dst, size_t n8) {
    const size_t gtid = (size_t)blockIdx.x * 512 + threadIdx.x, gstride = (size_t)gridDim.x * 512;
    for (size_t i = gtid; i < n8; i += gstride) { const f32x4 a = *(const f32x4*)(src + i * 8), b = *(const f32x4*)(src + i * 8 + 4);
        u32x4 o; o.x = cvt_pk_bf16(a[0], a[1]); o.y = cvt_pk_bf16(a[2], a[3]); o.z = cvt_pk_bf16(b[0], b[1]); o.w = cvt_pk_bf16(b[2], b[3]); *(u32x4*)(dst + i * 8) = o; }
}

__device__ void convert_fp8(const float* __restrict__ src, unsigned char* __restrict__ dst, size_t n16, float scale, int bid, int nb) {
    const size_t gtid = (size_t)bid * 512 + threadIdx.x, gstride = (size_t)nb * 512;
    for (size_t i = gtid; i < n16; i += gstride) { u32x4 o;
#pragma unroll
        for (int q = 0; q < 4; ++q) { const f32x4 a = *(const f32x4*)(src + i * 16 + q * 4) * scale;
            int pk = __builtin_amdgcn_cvt_pk_fp8_f32(a[0], a[1], 0, false); pk = __builtin_amdgcn_cvt_pk_fp8_f32(a[2], a[3], pk, true); o[q] = (unsigned)pk; }
        *(u32x4*)(dst + i * 16) = o; }
}
__device__ __forceinline__ float dot16_fp8(const u32x4 u, const f32x2 (&hp)[8]) {
    const int w0 = (int)u.x, w1 = (int)u.y, w2 = (int)u.z, w3 = (int)u.w;
    f32x2 s = __builtin_amdgcn_cvt_pk_f32_fp8(w0, false) * hp[0]; s += __builtin_amdgcn_cvt_pk_f32_fp8(w0, true) * hp[1];
    s += __builtin_amdgcn_cvt_pk_f32_fp8(w1, false) * hp[2]; s += __builtin_amdgcn_cvt_pk_f32_fp8(w1, true) * hp[3];
    s += __builtin_amdgcn_cvt_pk_f32_fp8(w2, false) * hp[4]; s += __builtin_amdgcn_cvt_pk_f32_fp8(w2, true) * hp[5];
    s += __builtin_amdgcn_cvt_pk_f32_fp8(w3, false) * hp[6]; s += __builtin_amdgcn_cvt_pk_f32_fp8(w3, true) * hp[7];
    return s.x + s.y;
}
__device__ __forceinline__ void axpy16_fp8(f32x2 (&oa)[8], const u32x4 v, float a) {
    const int w0 = (int)v.x, w1 = (int)v.y, w2 = (int)v.z, w3 = (int)v.w;
    oa[0] += __builtin_amdgcn_cvt_pk_f32_fp8(w0, false) * a; oa[1] += __builtin_amdgcn_cvt_pk_f32_fp8(w0, true) * a;
    oa[2] += __builtin_amdgcn_cvt_pk_f32_fp8(w1, false) * a; oa[3] += __builtin_amdgcn_cvt_pk_f32_fp8(w1, true) * a;
    oa[4] += __builtin_amdgcn_cvt_pk_f32_fp8(w2, false) * a; oa[5] += __builtin_amdgcn_cvt_pk_f32_fp8(w2, true) * a;
    oa[6] += __builtin_amdgcn_cvt_pk_f32_fp8(w3, false) * a; oa[7] += __builtin_amdgcn_cvt_pk_f32_fp8(w3, true) * a;
}
__device__ __forceinline__ float gelu_erf(float v) {
    const float av = fabsf(v), t = 1.0f / (1.0f + 0.2316418882f * av);
    float q = t * 0.5307027145f + (-0.7265760135f); q = q * t + 0.7107068705f; q = q * t + (-0.142248368f); q = q * t + 0.127414796f; q = q * t;
    const float e = __expf(-0.5f * v * v); const float mm = v * (q * e); return v < 0.f ? mm : v - mm;
}
__device__ __forceinline__ float dot2u(unsigned a, unsigned b, float acc) { return __builtin_amdgcn_fdot2_f32_bf16(__builtin_bit_cast(bf2_t, a), __builtin_bit_cast(bf2_t, b), acc, false); }
__device__ __forceinline__ float dot16(const u32x4 a0, const u32x4 a1, const u32x4 h0, const u32x4 h1) {
    const unsigned ax = a0.x, ay = a0.y, az = a0.z, aw = a0.w, bx = a1.x, by = a1.y, bz = a1.z, bw = a1.w;
    const unsigned hx = h0.x, hy = h0.y, hz = h0.z, hw = h0.w, gx = h1.x, gy = h1.y, gz = h1.z, gw_ = h1.w;
    float s0 = 0.f, s1 = 0.f;
    s0 = dot2u(ax, hx, s0); s1 = dot2u(ay, hy, s1); s0 = dot2u(az, hz, s0); s1 = dot2u(aw, hw, s1);
    s0 = dot2u(bx, gx, s0); s1 = dot2u(by, gy, s1); s0 = dot2u(bz, gz, s0); s1 = dot2u(bw, gw_, s1);
    return s0 + s1;
}
__device__ __forceinline__ int top16_of_2(int x0, int x1, int li) {
    int sorted = 0; const int NEG = (int)0x80000000; const int l2 = (int)(threadIdx.x & 63) * 2;
#pragma unroll
    for (int r = 0; r < 16; ++r) { const int mx = wave_max_i(max(x0, x1)); const int widx = sortkey(mx) & 127;
        x0 = (widx == l2) ? NEG : x0; x1 = (widx == l2 + 1) ? NEG : x1;
        sorted = (li == r) ? mx : sorted; }
    return sorted;
}
__device__ __forceinline__ int rowmax_i(int x) {
    x = max(x, __builtin_amdgcn_mov_dpp(x, 0xB1, 0xF, 0xF, true)); x = max(x, __builtin_amdgcn_mov_dpp(x, 0x4E, 0xF, 0xF, true));
    x = max(x, __builtin_amdgcn_mov_dpp(x, 0x141, 0xF, 0xF, true)); x = max(x, __builtin_amdgcn_mov_dpp(x, 0x140, 0xF, 0xF, true)); return x;
}
#define PEER_CE(a, b) do { const int hi_ = max(k[a], k[b]), lo_ = min(k[a], k[b]); k[a] = hi_; k[b] = lo_; } while (0)
__device__ __forceinline__ int top16_rows(const u32x4 w, int li) {
    int k[8]; const int base = li * 8; const unsigned w0 = w.x, w1 = w.y, w2 = w.z, w3 = w.w;
    k[0] = sortkey((int)((w0 << 16) | (unsigned)(base + 0))); k[1] = sortkey((int)((w0 & 0xffff0000u) | (unsigned)(base + 1)));
    k[2] = sortkey((int)((w1 << 16) | (unsigned)(base + 2))); k[3] = sortkey((int)((w1 & 0xffff0000u) | (unsigned)(base + 3)));
    k[4] = sortkey((int)((w2 << 16) | (unsigned)(base + 4))); k[5] = sortkey((int)((w2 & 0xffff0000u) | (unsigned)(base + 5)));
    k[6] = sortkey((int)((w3 << 16) | (unsigned)(base + 6))); k[7] = sortkey((int)((w3 & 0xffff0000u) | (unsigned)(base + 7)));
    PEER_CE(0, 1); PEER_CE(2, 3); PEER_CE(4, 5); PEER_CE(6, 7); PEER_CE(0, 2); PEER_CE(1, 3); PEER_CE(4, 6); PEER_CE(5, 7); PEER_CE(1, 2); PEER_CE(5, 6);
    PEER_CE(0, 4); PEER_CE(1, 5); PEER_CE(2, 6); PEER_CE(3, 7); PEER_CE(2, 4); PEER_CE(3, 5); PEER_CE(1, 2); PEER_CE(3, 4); PEER_CE(5, 6);
    int sorted = 0; const int NEG = (int)0x80000000;
#pragma unroll
    for (int r = 0; r < 16; ++r) { const int m = rowmax_i(k[0]); const bool win = (k[0] == m);
        k[0] = win ? k[1] : k[0]; k[1] = win ? k[2] : k[1]; k[2] = win ? k[3] : k[2]; k[3] = win ? k[4] : k[3];
        k[4] = win ? k[5] : k[4]; k[5] = win ? k[6] : k[5]; k[6] = win ? k[7] : k[6]; k[7] = win ? NEG : k[7];
        sorted = (li == r) ? m : sorted; }
    return sorted;
}
__device__ __forceinline__ void axpy16(float (&oa)[16], const u32x4 v0, const u32x4 v1, float a) {
    oa[0] += a * bflo(v0.x); oa[1] += a * bfhi(v0.x); oa[2] += a * bflo(v0.y); oa[3] += a * bfhi(v0.y); oa[4] += a * bflo(v0.z); oa[5] += a * bfhi(v0.z); oa[6] += a * bflo(v0.w); oa[7] += a * bfhi(v0.w);
    oa[8] += a * bflo(v1.x); oa[9] += a * bfhi(v1.x); oa[10] += a * bflo(v1.y); oa[11] += a * bfhi(v1.y); oa[12] += a * bflo(v1.z); oa[13] += a * bfhi(v1.z); oa[14] += a * bflo(v1.w); oa[15] += a * bfhi(v1.w);
}
__device__ void phase_peer(const Params& P, const bf16_t* __restrict__ h2, const bf16_t* __restrict__ scores, const unsigned char* __restrict__ U8, const unsigned char* __restrict__ V8) {
    const int lane = threadIdx.x & 63, li = lane & 15, gw = blockIdx.x * 8 + (threadIdx.x >> 6), nw = gridDim.x * 8;
    const float* ada = (const float*)(P.ws + OFF_ADA);
    const unsigned ct = cand_tab[lane]; const int ca = ct >> 4, cb = ct & 15; const bool cvalid = ct != 0xffu;
    for (int t = gw; t < NTOK; t += nw) {
        const int b = t / SEQL;
        f32x2 hp[8];
        { const u32x4 hA = *(const u32x4*)(h2 + (size_t)t * DM + lane * 16), hB = *(const u32x4*)(h2 + (size_t)t * DM + lane * 16 + 8);
          hp[0] = (f32x2){bflo(hA.x), bfhi(hA.x)}; hp[1] = (f32x2){bflo(hA.y), bfhi(hA.y)}; hp[2] = (f32x2){bflo(hA.z), bfhi(hA.z)}; hp[3] = (f32x2){bflo(hA.w), bfhi(hA.w)};
          hp[4] = (f32x2){bflo(hB.x), bfhi(hB.x)}; hp[5] = (f32x2){bflo(hB.y), bfhi(hB.y)}; hp[6] = (f32x2){bflo(hB.z), bfhi(hB.z)}; hp[7] = (f32x2){bflo(hB.w), bfhi(hB.w)}; }
        f32x2 oa[8]; int srtP = 0;
#pragma unroll
        for (int j = 0; j < 8; ++j) oa[j] = (f32x2){0.f, 0.f};
        auto topk = [&](int hd, int& we, float& gwt) {
            if ((hd & 1) == 0) srtP = top16_rows(*(const u32x4*)(scores + (size_t)t * 2048 + (hd + (lane >> 5)) * 256 + ((lane >> 4) & 1) * 128 + li * 8), li);
            const int rb = (hd & 1) * 32;
            const int fa = sortkey(__shfl(srtP, rb + ca)), fb = sortkey(__shfl(srtP, rb + 16 + cb));
            const int eid = (fa & 127) * 128 + (fb & 127);
            int ck = cvalid ? sortkey((int)((__float_as_uint(__int_as_float(fa) + __int_as_float(fb)) & ~63u) | (unsigned)lane)) : (int)0x80000000;
            float wsc = 0.f; we = 0;
#pragma unroll
            for (int r = 0; r < 16; ++r) { const int mx = wave_max_i(ck); const int fm = sortkey(mx); const int wl = fm & 63;
                const int ee = __builtin_amdgcn_readlane(eid, wl);
                ck = (wl == lane) ? (int)0x80000000 : ck;
                wsc = (li == r) ? __int_as_float(fm) : wsc; we = (li == r) ? ee : we; }
            const float smax = __int_as_float(__builtin_amdgcn_readlane(__float_as_int(wsc), 0));
            const float ex = __expf(wsc - smax); gwt = ex / row_sum16(ex);
        };
        int we_c = 0; float gw_c = 0.f; topk(0, we_c, gw_c);
        u32x4 uu[16], vv_[16];
#pragma unroll
        for (int j = 0; j < 16; ++j) { const int e = __builtin_amdgcn_readlane(we_c, j); uu[j] = *(const u32x4*)(U8 + (size_t)e * DM + lane * 16); }
#pragma unroll 1
        for (int hd = 0; hd < 8; ++hd) {
#pragma unroll
            for (int j = 0; j < 16; ++j) { const int e = __builtin_amdgcn_readlane(we_c, j); vv_[j] = *(const u32x4*)(V8 + (size_t)e * DM + lane * 16); }
            __builtin_amdgcn_sched_barrier(0);
            int we_n = 0; float gw_n = 0.f;
            if (hd < 7) topk(hd + 1, we_n, gw_n);
            __builtin_amdgcn_sched_barrier(0);
            float pd[16];
#pragma unroll
            for (int j = 0; j < 16; ++j) pd[j] = dot16_fp8(uu[j], hp);
            float q8[8];
            { const bool hi = (li & 8) != 0;
#pragma unroll
              for (int j = 0; j < 8; ++j) { const float send = hi ? pd[j] : pd[j + 8], keep = hi ? pd[j + 8] : pd[j]; q8[j] = keep + dppf0<0x140>(send); } }
            float q4[4];
            { const bool hi = (li & 4) != 0;
#pragma unroll
              for (int j = 0; j < 4; ++j) { const float send = hi ? q8[j] : q8[j + 4], keep = hi ? q8[j + 4] : q8[j]; q4[j] = keep + dppf0<0x141>(send); } }
            float q2[2];
            { const bool hi = (li & 2) != 0;
#pragma unroll
              for (int j = 0; j < 2; ++j) { const float send = hi ? q4[j] : q4[j + 2], keep = hi ? q4[j + 2] : q4[j]; q2[j] = keep + dppf0<0x1B>(send); } }
            float dsum;
            { const bool hi = (li & 1) != 0; const float send = hi ? q2[0] : q2[1], keep = hi ? q2[1] : q2[0]; dsum = keep + dppf0<0xB1>(send); }
            dsum += __shfl_xor(dsum, 16); dsum += __shfl_xor(dsum, 32);
            const float act = gelu_erf(dsum * (1.0f / 32.0f)) * gw_c * (1.0f / 16.0f);
            __builtin_amdgcn_sched_barrier(0);
            if (hd < 7) {
#pragma unroll
                for (int j = 0; j < 16; ++j) { const int e = __builtin_amdgcn_readlane(we_n, j); uu[j] = *(const u32x4*)(U8 + (size_t)e * DM + lane * 16); } }
            __builtin_amdgcn_sched_barrier(0);
#pragma unroll
            for (int j = 0; j < 16; ++j) { const float a = __int_as_float(__builtin_amdgcn_readlane(__float_as_int(act), j)); axpy16_fp8(oa, vv_[j], a); }
            we_c = we_n; gw_c = gw_n;
        }
        float* op = P.out + (size_t)t * DM + lane * 16; const float* g2p = ada + b * 6144 + 5120 + lane * 16;
#pragma unroll
        for (int q = 0; q < 4; ++q) { const f32x4 xv = *(const f32x4*)(op + q * 4), gv = *(const f32x4*)(g2p + q * 4);
            f32x4 r; r[0] = xv[0] + gv[0] * oa[q * 2].x; r[1] = xv[1] + gv[1] * oa[q * 2].y; r[2] = xv[2] + gv[2] * oa[q * 2 + 1].x; r[3] = xv[3] + gv[3] * oa[q * 2 + 1].y;
            *(f32x4*)(op + q * 4) = r; }
    }
}

__device__ __forceinline__ void gbar(unsigned* ctr, unsigned target) {
    __syncthreads();
    if (threadIdx.x == 0) {
        __builtin_amdgcn_fence(__ATOMIC_RELEASE, "agent");
        __hip_atomic_fetch_add(ctr, 1u, __ATOMIC_RELAXED, __HIP_MEMORY_SCOPE_AGENT);
        while (__hip_atomic_load(ctr, __ATOMIC_RELAXED, __HIP_MEMORY_SCOPE_AGENT) < target) __builtin_amdgcn_s_sleep(2);
        __builtin_amdgcn_fence(__ATOMIC_ACQUIRE, "agent");
        asm volatile("s_waitcnt vmcnt(0)" ::: "memory");
    }
    __syncthreads();
}
__global__ void __launch_bounds__(512) fwd_megakernel(Params P) {
    extern __shared__ __attribute__((aligned(16))) unsigned char smem[];
    cg::grid_group grid = cg::this_grid();
    unsigned char* ws = P.ws; PG8_LAS unsigned char* lds = (PG8_LAS unsigned char*)smem;
    bf16_t* hbf = (bf16_t*)(ws + OFF_HBF); bf16_t* projR = (bf16_t*)(ws + OFF_PR); bf16_t* projM = (bf16_t*)(ws + OFF_PM); bf16_t* projG = (bf16_t*)(ws + OFF_PG);
    float* ada = (float*)(ws + OFF_ADA);
    ScanBufs S; S.sr = hbf; S.sw = hbf + (size_t)NTOK * 512; S.sk = (bf16_t*)(ws + OFF_FREE); S.sv = S.sk + (size_t)NTOK * 512;
    S.skk = (bf16_t*)P.out; S.sb = S.skk + (size_t)NTOK * 512; S.g1 = S.sb + (size_t)NTOK * 512; S.g2 = S.g1 + (size_t)NTOK * 512;
    float* Oraw = (float*)projR; bf16_t* ya = projR + (size_t)NTOK * 1024; bf16_t* yb = ya + (size_t)NTOK * 512; bf16_t* t0 = projM; bf16_t* mix = hbf;
    bf16_t* h2 = projR + (size_t)NTOK * 1024; bf16_t* scores = projG; unsigned char* U8 = (unsigned char*)projM + 64 * MIB; unsigned char* V8 = U8 + (size_t)16384 * 1024;
    StaticOrder so; unsigned* bar = (unsigned*)(ws + OFF_CTL);

    phase0_ada(P, smem);
    grid.sync();
    phase_norm(P.x, P.norm1_g, ada, 0, 1024, hbf);
    phase0_weights(P);
    gbar(bar, 1u * gridDim.x);
    { Gemm g{hbf, (const bf16_t*)(ws + OFF_WIN), NTOK, 5632, 1024}; so.init(NTOK, 5632, gridDim.x, blockIdx.x); EpiProj e{projR, projM, projG}; gemm_phase(lds, g, so, e, nullptr); }
    gbar(bar, 2u * gridDim.x);
    phase_rwkv_prep(P, S, smem);
    __syncthreads();
    phase_moba_prep(P, smem);
    gbar(bar, 3u * gridDim.x);
    { const int nscan = gridDim.x >= 256 ? 128 : gridDim.x;
      if ((int)blockIdx.x < nscan) phase_scan(P, S, Oraw, smem, blockIdx.x, nscan, bar + 512);
      phase_moba(P, yb, smem, bar + 16, bar + 160);
      const int ebase = gridDim.x >= 256 ? nscan : 0, enb = (int)gridDim.x - ebase;
      if ((int)blockIdx.x >= ebase) {
          if (threadIdx.x == 0) { while (__hip_atomic_load(bar + 160, __ATOMIC_RELAXED, __HIP_MEMORY_SCOPE_AGENT) < 1024u) __builtin_amdgcn_s_sleep(8);
              __builtin_amdgcn_fence(__ATOMIC_ACQUIRE, "agent"); asm volatile("s_waitcnt vmcnt(0)" ::: "memory"); }
          __syncthreads();
          so.init(NTOK, 1024, enb, (int)blockIdx.x - ebase);
          Gemm gb{yb, (const bf16_t*)(ws + OFF_WBR) + 1024 * 512, NTOK, 1024, 512}; EpiMerge<0, 1024> eb{projG, t0, mix}; gemm_phase(lds, gb, so, eb, nullptr);
          convert_fp8(P.peer_u, U8, (size_t)16384 * 1024 / 16, 32.0f, (int)blockIdx.x - ebase, enb);
          convert_fp8(P.peer_v, V8, (size_t)16384 * 1024 / 16, 16.0f, (int)blockIdx.x - ebase, enb);
          __syncthreads();
          phase0_weights_late(P, smem, (int)blockIdx.x - ebase, enb);
          phase_gn(S, Oraw, ya, (int)blockIdx.x - ebase, enb, bar + 512);
      } }
    gbar(bar, 4u * gridDim.x);
    { so.init(NTOK, 1024, gridDim.x, blockIdx.x); Gemm ga{ya, (const bf16_t*)(ws + OFF_WBR), NTOK, 1024, 512}; EpiMerge<1, 0> ea{projG, t0, mix}; gemm_phase(lds, ga, so, ea, nullptr); }
    gbar(bar, 5u * gridDim.x);
    { so.init(NTOK, 1024, gridDim.x, blockIdx.x); Gemm g{mix, (const bf16_t*)(ws + OFF_WOUT), NTOK, 1024, 1024}; EpiOut e{P.x, ada, P.out}; gemm_phase(lds, g, so, e, nullptr); }
    gbar(bar, 6u * gridDim.x);
    phase_norm(P.out, P.norm2_g, ada, 3072, 4096, h2);
    gbar(bar, 7u * gridDim.x);
    { so.init(NTOK, 2048, gridDim.x, blockIdx.x); Gemm g{h2, (const bf16_t*)(ws + OFF_WC), NTOK, 2048, 1024}; EpiScore e{scores}; gemm_phase(lds, g, so, e, nullptr); }
    gbar(bar, 8u * gridDim.x);
    phase_peer(P, h2, scores, U8, V8);
}

extern "C" void kernel_launch(void* const* d_in, const int* in_sizes, int n_in, void* d_out, int out_size, void* d_ws, size_t ws_size, hipStream_t stream) {
    static int grid = 0;
    if (grid == 0) {
        int dev = 0, cus = 0, per_cu = 0;
        hipGetDevice(&dev); hipDeviceGetAttribute(&cus, hipDeviceAttributeMultiprocessorCount, dev);
        hipFuncSetAttribute((const void*)fwd_megakernel, hipFuncAttributeMaxDynamicSharedMemorySize, LDS_BYTES);
        hipOccupancyMaxActiveBlocksPerMultiprocessor(&per_cu, (const void*)fwd_megakernel, 512, LDS_BYTES);
        (void)hipGetLastError();
        if (per_cu < 1) per_cu = 1;
        grid = cus > 0 ? cus : 256;
    }
    (void)hipMemsetAsync((char*)d_ws + OFF_CTL, 0, 16384, stream);
    Params p{};
    const float** f = (const float**)&p;
    for (int i = 0; i < 26; ++i) f[i] = (const float*)d_in[i];
    p.out = (float*)d_out; p.ws = (unsigned char*)d_ws;
    void* args[] = {&p};
    hipError_t e = hipLaunchCooperativeKernel((const void*)fwd_megakernel, dim3(grid), dim3(512), args, LDS_BYTES, stream);
    if (e != hipSuccess) fprintf(stderr, "cooperative launch failed: %s (grid %d)\n", hipGetErrorString(e), grid);
}
```
